# Optimizing an MI355X kernel written in HIP

```python
import math
import jax, jax.numpy as jnp
from jax import lax
import numpy as np

D_MODEL = 1024
BATCH = 8
SEQ = 4096
DEPTH = 1

CHUNK = 64
D_MIX = D_MODEL
D_RWKV = D_MIX // 2
D_CONV = D_MIX - D_RWKV
HEAD_SIZE = 64
N_HEADS = D_RWKV // HEAD_SIZE
LORA_W = 64
LORA_A = 64
LORA_G = 128
CONV_WIDTH = 31
D_FF = 2816
D_SHIFT = 3 * D_RWKV + LORA_W + LORA_A + LORA_G
D_IN = D_SHIFT + 2 * D_CONV
RMS_EPS = 1e-6
GN_EPS = 64e-5
LN_EPS = 1e-5
DECAY_SCALE = math.exp(-0.5)

kernel_name = "hybrid_rwkv7_conformer_conv_macaron_block"


def rmsnorm(x, g):
    xf = x.astype(jnp.float32)
    y = xf * lax.rsqrt(jnp.mean(xf * xf, axis=-1, keepdims=True) + RMS_EPS)
    return (y * g.astype(jnp.float32)).astype(x.dtype)


def layernorm(x, g, b):
    xf = x.astype(jnp.float32)
    mu = jnp.mean(xf, axis=-1, keepdims=True)
    var = jnp.mean(jnp.square(xf - mu), axis=-1, keepdims=True)
    y = (xf - mu) * lax.rsqrt(var + LN_EPS)
    return (y * g.astype(jnp.float32) + b.astype(jnp.float32)).astype(x.dtype)


def swiglu(x, w_gu, w_down):
    gu = x @ w_gu
    gate, up = gu[..., :D_FF], gu[..., D_FF:]
    return (jax.nn.silu(gate) * up) @ w_down


def token_shift(y):
    return jnp.pad(y[:, :-1], ((0, 0), (1, 0), (0, 0)))


def rwkv7_recurrence(r, w, k, v, z, b):
    bsz, seq, nh, n = r.shape
    n_chunks = seq // CHUNK

    def to_chunks(t):
        return jnp.transpose(t, (1, 0, 2, 3)).reshape(n_chunks, CHUNK, bsz, nh, n)

    xs = tuple(to_chunks(t) for t in (r, w, k, v, z, b))

    def frame_step(state, inp):
        r_t, w_t, k_t, v_t, z_t, b_t = inp
        sz = jnp.einsum('bhij,bhj->bhi', state, z_t)
        state = (state * w_t[:, :, None, :]
                 + sz[..., None] * b_t[:, :, None, :]
                 + v_t[..., None] * k_t[:, :, None, :])
        y_t = jnp.einsum('bhij,bhj->bhi', state, r_t)
        return state, y_t

    def chunk_step(state, chunk_inp):
        return lax.scan(frame_step, state, chunk_inp)

    state0 = jnp.zeros((bsz, nh, n, n), jnp.float32)
    _, ys = lax.scan(chunk_step, state0, xs)
    ys = ys.reshape(seq, bsz, nh, n)
    return jnp.transpose(ys, (1, 0, 2, 3))


def hybrid_mixer(h, w_in, shift_mu, w_up, w0, a_up, a0, g_up, k_k, k_a, r_k,
                 gn_w, gn_b, conv_dw, conv_b, conv_ln_w, conv_ln_b, w_out):
    bsz, seq, _ = h.shape
    p = h @ w_in
    ps, pc = p[..., :D_SHIFT], p[..., D_SHIFT:]

    ps = ps + (token_shift(ps) - ps) * shift_mu
    o1, o2, o3 = D_RWKV, 2 * D_RWKV, 3 * D_RWKV
    o4, o5 = o3 + LORA_W, o3 + LORA_W + LORA_A
    r, k, v = ps[..., :o1], ps[..., o1:o2], ps[..., o2:o3]
    xw, xa, xg = ps[..., o3:o4], ps[..., o4:o5], ps[..., o5:]

    d = (w0 + jnp.tanh(xw) @ w_up).astype(jnp.float32)
    decay = jnp.exp(-DECAY_SCALE * jax.nn.sigmoid(d))
    a = jax.nn.sigmoid(a0 + xa @ a_up)
    g = jax.nn.sigmoid(xg) @ g_up

    heads = lambda t: t.reshape(bsz, seq, N_HEADS, HEAD_SIZE).astype(jnp.float32)
    kk = heads(k * k_k)
    kk = kk * lax.rsqrt(jnp.maximum(jnp.sum(kk * kk, axis=-1, keepdims=True), 1e-12))
    k = k * (1.0 + (a - 1.0) * k_a)
    rh, kh, vh, ah, wh = heads(r), heads(k), heads(v), heads(a), heads(decay)

    y = rwkv7_recurrence(rh, wh, kh, vh, -kk, kk * ah)
    mu = jnp.mean(y, axis=-1, keepdims=True)
    var = jnp.mean(jnp.square(y - mu), axis=-1, keepdims=True)
    y = (y - mu) * lax.rsqrt(var + GN_EPS)
    y = y * gn_w.astype(jnp.float32).reshape(N_HEADS, HEAD_SIZE) + gn_b.astype(jnp.float32).reshape(N_HEADS, HEAD_SIZE)
    bonus = jnp.sum(rh * kh * r_k.astype(jnp.float32), axis=-1, keepdims=True) * vh
    y = (y + bonus).reshape(bsz, seq, D_RWKV).astype(h.dtype)
    out_a = y * g

    glu = pc[..., :D_CONV] * jax.nn.sigmoid(pc[..., D_CONV:])
    c = lax.conv_general_dilated(
        glu, conv_dw[:, None, :], window_strides=(1,),
        padding=[(CONV_WIDTH - 1, 0)],
        dimension_numbers=('NWC', 'WIO', 'NWC'),
        feature_group_count=D_CONV) + conv_b
    out_b = jax.nn.silu(layernorm(c, conv_ln_w, conv_ln_b))

    return jnp.concatenate([out_a, out_b], axis=-1) @ w_out


def setup_inputs(seed: int = 0) -> dict:
    key = jax.random.key(seed)
    ks = iter(jax.random.split(key, 40))
    f32 = jnp.float32

    def nrm(shape, scale):
        return jax.random.normal(next(ks), shape, f32) * scale

    def gain(shape):
        return 1.0 + nrm(shape, 0.02)

    L = DEPTH
    return {
        "x": nrm((BATCH, SEQ, D_MODEL), 1.0),
        "ffn1_norm_pre": gain((L, D_MODEL)),
        "ffn1_norm_post": gain((L, D_MODEL)),
        "ffn1_w_gu": nrm((L, D_MODEL, 2 * D_FF), D_MODEL ** -0.5),
        "ffn1_w_down": nrm((L, D_FF, D_MODEL), D_FF ** -0.5),
        "mix_norm_pre": gain((L, D_MODEL)),
        "mix_norm_post": gain((L, D_MODEL)),
        "w_in": nrm((L, D_MODEL, D_IN), D_MODEL ** -0.5),
        "shift_mu": jax.random.uniform(next(ks), (L, D_SHIFT), f32, 0.1, 0.9),
        "w_up": nrm((L, LORA_W, D_RWKV), 0.3 * LORA_W ** -0.5),
        "w0": nrm((L, D_RWKV), 0.5),
        "a_up": nrm((L, LORA_A, D_RWKV), 0.3 * LORA_A ** -0.5),
        "a0": nrm((L, D_RWKV), 0.1),
        "g_up": nrm((L, LORA_G, D_RWKV), LORA_G ** -0.5),
        "k_k": 0.85 + nrm((L, D_RWKV), 0.02),
        "k_a": 1.0 + nrm((L, D_RWKV), 0.02),
        "r_k": nrm((L, N_HEADS, HEAD_SIZE), 0.1),
        "gn_w": gain((L, D_RWKV)),
        "gn_b": nrm((L, D_RWKV), 0.01),
        "conv_dw": nrm((L, CONV_WIDTH, D_CONV), CONV_WIDTH ** -0.5),
        "conv_b": nrm((L, D_CONV), 0.01),
        "conv_ln_w": gain((L, D_CONV)),
        "conv_ln_b": nrm((L, D_CONV), 0.01),
        "w_out": nrm((L, D_MIX, D_MODEL), D_MIX ** -0.5),
        "ffn2_norm_pre": gain((L, D_MODEL)),
        "ffn2_norm_post": gain((L, D_MODEL)),
        "ffn2_w_gu": nrm((L, D_MODEL, 2 * D_FF), D_MODEL ** -0.5),
        "ffn2_w_down": nrm((L, D_FF, D_MODEL), D_FF ** -0.5),
    }


def reference(x, ffn1_norm_pre, ffn1_norm_post, ffn1_w_gu, ffn1_w_down,
              mix_norm_pre, mix_norm_post, w_in, shift_mu, w_up, w0, a_up, a0,
              g_up, k_k, k_a, r_k, gn_w, gn_b, conv_dw, conv_b, conv_ln_w,
              conv_ln_b, w_out, ffn2_norm_pre, ffn2_norm_post, ffn2_w_gu,
              ffn2_w_down):
    for l in range(DEPTH):
        f = swiglu(rmsnorm(x, ffn1_norm_pre[l]), ffn1_w_gu[l], ffn1_w_down[l])
        x = x + 0.5 * rmsnorm(f, ffn1_norm_post[l])
        m = hybrid_mixer(rmsnorm(x, mix_norm_pre[l]), w_in[l], shift_mu[l], w_up[l],
                         w0[l], a_up[l], a0[l], g_up[l], k_k[l], k_a[l], r_k[l],
                         gn_w[l], gn_b[l], conv_dw[l], conv_b[l], conv_ln_w[l],
                         conv_ln_b[l], w_out[l])
        x = x + rmsnorm(m, mix_norm_post[l])
        f = swiglu(rmsnorm(x, ffn2_norm_pre[l]), ffn2_w_gu[l], ffn2_w_down[l])
        x = x + 0.5 * rmsnorm(f, ffn2_norm_post[l])
    return x
```

```cpp
#include <hip/hip_runtime.h>
#include <cstdio>
#include <cstdint>
namespace pg8 {
#define PG8_LAS __attribute__((address_space(3)))
typedef unsigned short bf16_t;
typedef short bf16x8 __attribute__((ext_vector_type(8)));
typedef float f32x4 __attribute__((ext_vector_type(4)));
typedef unsigned u32x4 __attribute__((ext_vector_type(4)));
constexpr int BM = 256, BK = 64, HALF = 128, HTB = HALF * BK * 2  , STAGE_BYTES = 8 * HTB, NXCD = 8, WGM = 8;

__host__ __device__ __forceinline__ int lds_byte(int r, int c) { const int st = (r >> 4) * 2 + (c >> 5), rr = r & 15, cc = c & 31, ob = rr * 64 + cc * 2; return st * 1024 + (ob ^ (((ob >> 9) & 1) << 5)); }
__host__ __device__ __forceinline__ void stage_rc(int b, int& R, int& C) { const int st = b / 1024, sb = b % 1024, swz = sb ^ (((sb >> 9) & 1) << 5); R = (st >> 1) * 16 + swz / 64; C = (st & 1) * 32 + (swz % 64) / 2; }
__host__ __device__ __forceinline__ int perm32(int rho) { const int n = rho >> 4, i = rho & 15; return 8 * (i >> 2) + 4 * n + (i & 3); }

struct Unit { int pm, pn; };
struct Gemm { const bf16_t* A; const bf16_t* Bt; int M, N, K; };

struct StaticOrder {
    int nM, nN, nwg, G, c;
    __host__ __device__ void init(int M, int N, int G_, int c_) { nM = M / BM; nN = N / BM; nwg = nM * nN; G = G_; c = c_; }
    __host__ __device__ bool next(int i, Unit& u) const {
        const long L = (long)i * G + c; if (L >= nwg) return false;
        int wgid = (int)L; { const int q = nwg / NXCD, r = nwg % NXCD, xcd = wgid % NXCD, off = wgid / NXCD; wgid = (xcd < r ? xcd * (q + 1) : r * (q + 1) + (xcd - r) * q) + off; }
        const int nig = WGM * nN, gid = wgid / nig, fm = gid * WGM, gsz = (nM - fm) < WGM ? (nM - fm) : WGM;
        u.pm = fm + ((wgid % nig) % gsz); u.pn = (wgid % nig) / gsz; return true;
    }
    __device__ __forceinline__ void a_ready(const Unit&) const {}
    __device__ __forceinline__ void done(const Unit&) const {}
};
__device__ __forceinline__ unsigned cvt_pk_bf16(float lo, float hi) { unsigned r; asm volatile("v_cvt_pk_bf16_f32 %0, %1, %2" : "=v"(r) : "v"(lo), "v"(hi)); return r; }
typedef float f32x2 __attribute__((ext_vector_type(2)));
__device__ __forceinline__ float silu_mul(float g, float u) { const float e = __builtin_amdgcn_exp2f(g * -1.44269504f); return g * __builtin_amdgcn_rcpf(1.0f + e) * u; }

struct EpiBf16 {
    static constexpr bool PERM = true, AFTER_DRAIN = false;
    bf16_t* O; int ldc;
    __device__ __forceinline__ void operator()(const f32x4 (&acc)[2][2][4][2], const Unit& u, int wr, int wc, int fr, int fq) const {
        const int row0 = u.pm * BM + wr * 64 + fr; const int col0 = u.pn * BM + wc * 32 + 8 * fq;
#pragma unroll
        for (int ai = 0; ai < 2; ++ai)
#pragma unroll
            for (int m = 0; m < 4; ++m) { bf16_t* rowp = O + (size_t)(row0 + ai * HALF + m * 16) * ldc + col0;
#pragma unroll
                for (int bj = 0; bj < 2; ++bj) { const f32x4 v0 = acc[ai][bj][m][0], v1 = acc[ai][bj][m][1];
                    u32x4 w; w.x = cvt_pk_bf16(v0[0], v0[1]); w.y = cvt_pk_bf16(v0[2], v0[3]); w.z = cvt_pk_bf16(v1[0], v1[1]); w.w = cvt_pk_bf16(v1[2], v1[3]);
                    *(u32x4*)(rowp + bj * HALF) = w; } }
    }
};
struct EpiSwiGLU {
    static constexpr bool PERM = true, AFTER_DRAIN = false;
    bf16_t* H; int ldh;
    __device__ __forceinline__ void operator()(const f32x4 (&acc)[2][2][4][2], const Unit& u, int wr, int wc, int fr, int fq) const {
        const int row0 = u.pm * BM + wr * 64 + fr; const int col0 = u.pn * HALF + wc * 32 + 8 * fq;
#pragma unroll
        for (int ai = 0; ai < 2; ++ai)
#pragma unroll
            for (int m = 0; m < 4; ++m) { bf16_t* rowp = H + (size_t)(row0 + ai * HALF + m * 16) * ldh + col0;
                const f32x4 g0 = acc[ai][0][m][0], g1 = acc[ai][0][m][1], u0 = acc[ai][1][m][0], u1 = acc[ai][1][m][1];
                u32x4 w; w.x = cvt_pk_bf16(silu_mul(g0[0], u0[0]), silu_mul(g0[1], u0[1])); w.y = cvt_pk_bf16(silu_mul(g0[2], u0[2]), silu_mul(g0[3], u0[3]));
                w.z = cvt_pk_bf16(silu_mul(g1[0], u1[0]), silu_mul(g1[1], u1[1])); w.w = cvt_pk_bf16(silu_mul(g1[2], u1[2]), silu_mul(g1[3], u1[3]));
                *(u32x4*)rowp = w; }
    }
};
struct EpiF32 {
    static constexpr bool PERM = false, AFTER_DRAIN = false;
    float* C; int ldc;
    __device__ __forceinline__ void operator()(const f32x4 (&acc)[2][2][4][2], const Unit& u, int wr, int wc, int fr, int fq) const {
        const int row0 = u.pm * BM + wr * 64 + fr, col0 = u.pn * BM + wc * 32 + 4 * fq;
#pragma unroll
        for (int ai = 0; ai < 2; ++ai)
#pragma unroll
            for (int m = 0; m < 4; ++m) { float* rowp = C + (size_t)(row0 + ai * HALF + m * 16) * ldc + col0;
#pragma unroll
                for (int bj = 0; bj < 2; ++bj)
#pragma unroll
                    for (int n = 0; n < 2; ++n) *(f32x4*)(rowp + bj * HALF + n * 16) = acc[ai][bj][m][n]; }
    }
};
template <class Epi, class Sched, bool ALIGN_EPI = false, bool SP2 = false>
__device__ __forceinline__ void gemm_phase(PG8_LAS unsigned char* lds, const Gemm g, const Sched& S, const Epi& E) {
    const int tid = threadIdx.x, wid = __builtin_amdgcn_readfirstlane(tid >> 6), lane = tid & 63, wr = wid >> 2, wc = wid & 3, fr = lane & 15, fq = lane >> 4;
    const int K = g.K, nt = K / BK;
    unsigned voffA[2], voffB[2];
#pragma unroll
    for (int i = 0; i < 2; ++i) { int R, C; stage_rc(tid * 16 + i * 8192, R, C); const int Rb = Epi::PERM ? ((R & ~31) + perm32(R & 31)) : R;
        voffA[i] = (unsigned)(R * K + C) * 2u; voffB[i] = (unsigned)(Rb * K + C) * 2u; }
    const size_t kstep = (size_t)(BK * 2);
    const size_t hstep = (size_t)HALF * K * 2;
    const size_t tstep = 2 * hstep;
    const unsigned ldsw = (unsigned)wid * 1024u;
    const int aoff = lds_byte(wr * 64 + fr, fq * 8), boff = lds_byte(wc * 32 + fr, fq * 8);
#define PG8_SA(b, h) (((b) * 2 + (h)) * HTB)
#define PG8_SB(b, h) ((4 + (b) * 2 + (h)) * HTB)
#define PG8_STAGE(bufoff, gbase, voff) do { _Pragma("unroll") for (int _i = 0; _i < 2; ++_i) \
        __builtin_amdgcn_global_load_lds((const unsigned*)((const char*)(gbase) + (voff)[_i]), (PG8_LAS unsigned*)(lds + (bufoff) + ldsw + _i * 8192), 16, 0, 0); } while (0)
#define PG8_LDA(dst, b, h) do { _Pragma("unroll") for (int m = 0; m < 4; ++m) _Pragma("unroll") for (int k = 0; k < 2; ++k) dst[m][k] = *(const PG8_LAS bf16x8*)(lds + PG8_SA(b, h) + aoff + m * 2048 + k * 1024); } while (0)
#define PG8_LDB(dst, b, h) do { _Pragma("unroll") for (int n = 0; n < 2; ++n) _Pragma("unroll") for (int k = 0; k < 2; ++k) dst[n][k] = *(const PG8_LAS bf16x8*)(lds + PG8_SB(b, h) + boff + n * 2048 + k * 1024); } while (0)
#define PG8_MMA(ai, bj, At, Bt) do { __builtin_amdgcn_s_setprio(1); _Pragma("unroll") for (int m = 0; m < 4; ++m) _Pragma("unroll") for (int n = 0; n < 2; ++n) _Pragma("unroll") for (int k = 0; k < 2; ++k) \
        acc[ai][bj][m][n] = __builtin_amdgcn_mfma_f32_16x16x32_bf16(Bt[n][k], At[m][k], acc[ai][bj][m][n], 0, 0, 0); __builtin_amdgcn_s_setprio(0); } while (0)
#define PG8_WAIT_V(n) asm volatile("s_waitcnt vmcnt(" #n ")" ::: "memory")
#define PG8_WAIT_L(n) asm volatile("s_waitcnt lgkmcnt(" #n ")" ::: "memory")
#define PG8_BAR __builtin_amdgcn_s_barrier()
#define PG8_SCHED __builtin_amdgcn_sched_barrier(0)
    Unit cur, nxt; int ui = 0;
    if (!S.next(0, cur)) return;
    f32x4 acc[2][2][4][2];
#pragma unroll
    for (int a = 0; a < 2; ++a)
#pragma unroll
        for (int b = 0; b < 2; ++b)
#pragma unroll
            for (int m = 0; m < 4; ++m)
#pragma unroll
                for (int n = 0; n < 2; ++n) acc[a][b][m][n] = (f32x4){0.f, 0.f, 0.f, 0.f};
    bf16x8 At[4][2], B0[2][2], B1[2][2];
    const char* cA = (const char*)g.A + (size_t)cur.pm * tstep; const char* cB = (const char*)g.Bt + (size_t)cur.pn * tstep;
    S.a_ready(cur);
    if constexpr (SP2) {
        PG8_STAGE(PG8_SB(0, 0), cB, voffB); PG8_STAGE(PG8_SB(0, 1), cB + hstep, voffB); PG8_STAGE(PG8_SA(0, 0), cA, voffA); PG8_STAGE(PG8_SA(0, 1), cA + hstep, voffA);
        if (wr == 1) PG8_BAR;
        PG8_WAIT_V(2); PG8_BAR;
        PG8_STAGE(PG8_SB(1, 0), cB + kstep, voffB); PG8_STAGE(PG8_SA(1, 0), cA + kstep, voffA); PG8_STAGE(PG8_SB(1, 1), cB + hstep + kstep, voffB);
        PG8_WAIT_V(6); PG8_BAR;
    } else {
        PG8_STAGE(PG8_SB(0, 0), cB, voffB); PG8_STAGE(PG8_SA(0, 0), cA, voffA); PG8_STAGE(PG8_SB(0, 1), cB + hstep, voffB); PG8_STAGE(PG8_SA(0, 1), cA + hstep, voffA);
        if (wr == 1) PG8_BAR;
        PG8_WAIT_V(4); PG8_BAR;
        PG8_STAGE(PG8_SB(1, 0), cB + kstep, voffB); PG8_STAGE(PG8_SA(1, 0), cA + kstep, voffA); PG8_STAGE(PG8_SB(1, 1), cB + hstep + kstep, voffB);
        PG8_WAIT_V(6); PG8_BAR;
    }
    for (;;) {
        const bool has_next = S.next(ui + 1, nxt);
        const char* nA = has_next ? (const char*)g.A + (size_t)nxt.pm * tstep : cA; const char* nB = has_next ? (const char*)g.Bt + (size_t)nxt.pn * tstep : cB;
        for (int t = 0; t < nt; t += 2) {
            const bool last = (t == nt - 2);
            const char* a1 = cA + (size_t)(t + 1) * kstep;
            const char* a2 = last ? nA : cA + (size_t)(t + 2) * kstep; const char* b2 = last ? nB : cB + (size_t)(t + 2) * kstep;
            const char* a3 = a2 + kstep; const char* b3 = b2 + kstep;
            if (last && has_next) S.a_ready(nxt);
            if constexpr (SP2) {
            PG8_LDB(B0, 0, 0); PG8_LDB(B1, 0, 1); PG8_SCHED; PG8_LDA(At, 0, 0); PG8_STAGE(PG8_SA(1, 1), a1 + hstep, voffA);
            PG8_WAIT_V(8); PG8_WAIT_L(0); PG8_BAR; PG8_MMA(0, 0, At, B0); PG8_MMA(0, 1, At, B1); PG8_BAR; PG8_SCHED;
            PG8_LDA(At, 0, 1); PG8_STAGE(PG8_SB(0, 0), b2, voffB); PG8_STAGE(PG8_SB(0, 1), b2 + hstep, voffB); PG8_STAGE(PG8_SA(0, 0), a2, voffA);
            PG8_WAIT_V(8); PG8_WAIT_L(0); PG8_BAR; PG8_MMA(1, 0, At, B0); PG8_MMA(1, 1, At, B1); PG8_BAR; PG8_SCHED;
            PG8_LDB(B0, 1, 0); PG8_LDB(B1, 1, 1); PG8_SCHED; PG8_LDA(At, 1, 0); PG8_STAGE(PG8_SA(0, 1), a2 + hstep, voffA);
            PG8_WAIT_V(8); PG8_WAIT_L(0); PG8_BAR; PG8_MMA(0, 0, At, B0); PG8_MMA(0, 1, At, B1); PG8_BAR; PG8_SCHED;
            PG8_LDA(At, 1, 1); PG8_STAGE(PG8_SB(1, 0), b3, voffB); PG8_STAGE(PG8_SB(1, 1), b3 + hstep, voffB); PG8_STAGE(PG8_SA(1, 0), a3, voffA);
            PG8_WAIT_V(8); PG8_WAIT_L(0); PG8_BAR; PG8_MMA(1, 0, At, B0); PG8_MMA(1, 1, At, B1); PG8_BAR; PG8_SCHED;
            } else {
            PG8_LDB(B0, 0, 0); PG8_SCHED; PG8_LDA(At, 0, 0); PG8_STAGE(PG8_SA(1, 1), a1 + hstep, voffA);
            PG8_WAIT_L(8); PG8_BAR; PG8_WAIT_L(0); PG8_MMA(0, 0, At, B0); PG8_BAR; PG8_SCHED;
            PG8_LDB(B1, 0, 1); PG8_STAGE(PG8_SB(0, 0), b2, voffB);
            PG8_BAR; PG8_WAIT_L(0); PG8_MMA(0, 1, At, B1); PG8_BAR;
            PG8_LDA(At, 0, 1); PG8_STAGE(PG8_SA(0, 0), a2, voffA);
            PG8_BAR; PG8_WAIT_L(0); PG8_MMA(1, 0, At, B0); PG8_BAR; PG8_SCHED;
            PG8_STAGE(PG8_SB(0, 1), b2 + hstep, voffB);
            PG8_WAIT_V(6); PG8_BAR; PG8_MMA(1, 1, At, B1); PG8_BAR;
            PG8_LDB(B0, 1, 0); PG8_SCHED; PG8_LDA(At, 1, 0); PG8_STAGE(PG8_SA(0, 1), a2 + hstep, voffA);
            PG8_WAIT_L(8); PG8_BAR; PG8_WAIT_L(0); PG8_MMA(0, 0, At, B0); PG8_BAR; PG8_SCHED;
            PG8_LDB(B1, 1, 1); PG8_STAGE(PG8_SB(1, 0), b3, voffB);
            PG8_BAR; PG8_WAIT_L(0); PG8_MMA(0, 1, At, B1); PG8_BAR;
            PG8_LDA(At, 1, 1); PG8_STAGE(PG8_SA(1, 0), a3, voffA);
            PG8_BAR; PG8_WAIT_L(0); PG8_MMA(1, 0, At, B0); PG8_BAR; PG8_SCHED;
            PG8_STAGE(PG8_SB(1, 1), b3 + hstep, voffB);
            PG8_WAIT_V(6); PG8_BAR; PG8_MMA(1, 1, At, B1); PG8_BAR;
            }
        }
        if constexpr (ALIGN_EPI) { if (wr == 0) PG8_BAR; }
        if constexpr (!Epi::AFTER_DRAIN) { E(acc, cur, wr, wc, fr, fq); S.done(cur); }
        if (!has_next) break;
#pragma unroll
        for (int a = 0; a < 2; ++a)
#pragma unroll
            for (int b = 0; b < 2; ++b)
#pragma unroll
                for (int m = 0; m < 4; ++m)
#pragma unroll
                    for (int n = 0; n < 2; ++n) acc[a][b][m][n] = (f32x4){0.f, 0.f, 0.f, 0.f};
        cur = nxt; cA = nA; cB = nB; ++ui;
        if constexpr (ALIGN_EPI) { if (wr == 1) PG8_BAR; }
    }
    PG8_WAIT_V(0);
    if constexpr (!ALIGN_EPI) { if (wr == 0) PG8_BAR; }
    PG8_BAR;
    if constexpr (Epi::AFTER_DRAIN) { E.fused(acc, cur, wr, wc, fr, fq, lds, wid, lane); S.done(cur); }
#undef PG8_SA
#undef PG8_SB
#undef PG8_STAGE
#undef PG8_LDA
#undef PG8_LDB
#undef PG8_MMA
#undef PG8_WAIT_V
#undef PG8_WAIT_L
#undef PG8_BAR
#undef PG8_SCHED
}
}
constexpr int NWAVES = 8;
constexpr int BATCH = 8, SEQ = 4096, D = 1024, M = BATCH * SEQ;
constexpr int DFF = 2816, NGU = 2 * DFF, DRW = 512, DCV = 512, NH = 8, HS = 64;
constexpr int DSHIFT = 3 * DRW + 64 + 64 + 128;
constexpr int DIN = DSHIFT + 2 * DCV;
constexpr int CONVW = 31;
constexpr float RMS_EPS = 1e-6f, GN_EPS = 64e-5f, LN_EPS = 1e-5f, DECAY_SCALE = 0.60653065971f;
#ifndef MK_ONE_LAUNCH
#define MK_ONE_LAUNCH 0
#endif
constexpr int N_PHASES = 11;

constexpr size_t MiB = 1u << 20;
constexpr size_t WS_CTL = 0, CTL_ZERO_BYTES = 1 * MiB;
constexpr size_t WS_WGU1 = 2 * MiB, WS_WDN1 = 13 * MiB, WS_WIN = 19 * MiB, WS_WOUT = 25 * MiB, WS_WGU2 = 27 * MiB, WS_WDN2 = 38 * MiB;
constexpr size_t WS_XN = 48 * MiB;
constexpr size_t WS_H = 112 * MiB;
constexpr size_t WS_F = 288 * MiB;
constexpr size_t WS_OAB = 416 * MiB;
constexpr size_t WS_END = 480 * MiB;
static_assert(WS_WGU1 + (size_t)NGU * D * 2 <= WS_WDN1 && WS_WDN1 + (size_t)D * DFF * 2 <= WS_WIN && WS_WIN + (size_t)DIN * D * 2 <= WS_WOUT && WS_WOUT + (size_t)D * D * 2 <= WS_WGU2 &&
              WS_WGU2 + (size_t)NGU * D * 2 <= WS_WDN2 && WS_WDN2 + (size_t)D * DFF * 2 <= WS_XN && WS_XN + (size_t)M * D * 2 <= WS_H && WS_H + (size_t)M * DFF * 2 <= WS_F &&
              WS_F + (size_t)M * D * 4 <= WS_OAB && WS_OAB + (size_t)M * D * 2 <= WS_END, "d_ws map");
constexpr int CW_TMO = 0, CW_CODE = 1;
constexpr int CW_BAR = 4096;

constexpr int RING_OFF = 0, RING_BYTES = 131072;
constexpr int LDSCTL_OFF = RING_BYTES, MISC_OFF = LDSCTL_OFF + 320;
constexpr int LDS_BYTES = 147456;
static_assert(MISC_OFF + 128 <= LDS_BYTES, "LDS map");
#define GAS __attribute__((address_space(1)))
#define LAS __attribute__((address_space(3)))
typedef unsigned short bf16;
typedef unsigned v4u __attribute__((ext_vector_type(4)));
typedef float f32x4 __attribute__((ext_vector_type(4)));
typedef short bf16x8 __attribute__((ext_vector_type(8)));
typedef GAS unsigned gu32;
typedef GAS unsigned long long gu64;
#define RLX_AGENT __ATOMIC_RELAXED, __HIP_MEMORY_SCOPE_AGENT
#define LDS_WAIT() asm volatile("s_waitcnt lgkmcnt(0)" ::: "memory")
#define VM_WAIT() asm volatile("s_waitcnt vmcnt(0)" ::: "memory")
__device__ __forceinline__ unsigned long long rt() { return __builtin_amdgcn_s_memrealtime(); }
__device__ __forceinline__ unsigned f2bf(float f) { unsigned u = __builtin_bit_cast(unsigned, f); return (u + 0x7fffu + ((u >> 16) & 1u)) >> 16; }
__device__ __forceinline__ unsigned pk2(float lo, float hi) { return f2bf(lo) | (f2bf(hi) << 16); }
#define XB_TMO      128
#define XB_XCNT(j)  (256  + 64 * (j))
#define XB_XSUB(j)  (1280 + 64 * (j))
#define XB_XGEN(j)  (2304 + 64 * (j))
#define XB_TOP      3328
#define XB_TOPGEN   3392
#define XCD_BAR_WORDS 3456
#define XB_SPIN_CAP (1u << 18)

__device__ __forceinline__ unsigned xb_ld(unsigned* p)              { return __hip_atomic_load(p, __ATOMIC_RELAXED, __HIP_MEMORY_SCOPE_AGENT); }
__device__ __forceinline__ unsigned xb_add(unsigned* p, unsigned v) { return __hip_atomic_fetch_add(p, v, __ATOMIC_RELAXED, __HIP_MEMORY_SCOPE_AGENT); }
__device__ __forceinline__ unsigned xb_xcc_id() { return (unsigned)__builtin_amdgcn_s_getreg((3 << 11) | 20) & 0xFu; }
#define XB_SPIN(cond, bar) do { unsigned _sp = 0; while (cond) { __builtin_amdgcn_s_sleep(1); \
    if ((++_sp & 255u) == 0u) { if (xb_ld(&(bar)[XB_TMO])) break; if (_sp > XB_SPIN_CAP) { atomicAdd(&(bar)[XB_TMO], 1u); break; } } } } while (0)

struct XcdBarrier {
    unsigned* bar; unsigned x;
    volatile LAS unsigned* st;
};

__device__ __forceinline__ XcdBarrier xcd_barrier_post(unsigned* bar, volatile LAS unsigned* st) {
    XcdBarrier b; b.bar = bar; b.x = xb_xcc_id(); b.st = st;
    if (threadIdx.x == 0) (void)xb_add(&bar[XB_XCNT(b.x)], 1u);
    return b;
}
__device__ __forceinline__ void xcd_barrier_complete(unsigned* bar, unsigned x, unsigned& nloc, unsigned& nx) {
    const unsigned G = gridDim.x * gridDim.y * gridDim.z;
    unsigned sum, cnt, mine, sp = 0u;
    for (;;) {
        sum = 0u; cnt = 0u; mine = 0u;
#pragma unroll
        for (unsigned j = 0; j < 16; ++j) { const unsigned c = xb_ld(&bar[XB_XCNT(j)]); sum += c; cnt += (c > 0u) ? 1u : 0u; mine = (j == x) ? c : mine; }
        if (sum == G) break;
        __builtin_amdgcn_s_sleep(1);
        if ((++sp & 255u) == 0u) { if (xb_ld(&bar[XB_TMO])) break; if (sp > XB_SPIN_CAP) { atomicAdd(&bar[XB_TMO], 1u); break; } }
    }
    nloc = mine > 0u ? mine : 1u; nx = cnt > 0u ? cnt : 1u;
}

__device__ __forceinline__ void xcd_barrier(const XcdBarrier& b) {
    asm volatile("s_waitcnt vmcnt(0)" ::: "memory");
    __syncthreads();
    if (threadIdx.x == 0) {
        unsigned* bar = b.bar;
        __builtin_amdgcn_s_waitcnt(0);
        unsigned nloc = b.st[0], nx = b.st[1];
        if (nloc == 0u) { xcd_barrier_complete(bar, b.x, nloc, nx); b.st[0] = nloc; b.st[1] = nx; }
        const unsigned old = xb_add(&bar[XB_XSUB(b.x)], 1u);
        const unsigned gen = old / nloc;
        if (old + 1u == (gen + 1u) * nloc) {
            __builtin_amdgcn_fence(__ATOMIC_RELEASE, "agent");
            asm volatile("s_waitcnt vmcnt(0)" ::: "memory");
            const unsigned og = xb_add(&bar[XB_TOP], 1u);
            const unsigned tg = og / nx;
            if (og + 1u == (tg + 1u) * nx) xb_add(&bar[XB_TOPGEN], 1u);
            else XB_SPIN(xb_ld(&bar[XB_TOPGEN]) == tg, bar);
            __builtin_amdgcn_fence(__ATOMIC_ACQUIRE, "agent");
            xb_add(&bar[XB_XGEN(b.x)], 1u);
            asm volatile("s_waitcnt vmcnt(0)" ::: "memory");
        } else {
            XB_SPIN(xb_ld(&bar[XB_XGEN(b.x)]) == gen, bar);
            __builtin_amdgcn_fence(__ATOMIC_ACQUIRE, "agent");
            asm volatile("s_waitcnt vmcnt(0)" ::: "memory");
        }
    }
    __syncthreads();
}
struct Frame {
    LAS unsigned char* lds;
    volatile LAS unsigned* MISC;
    gu32* ctl;
    int tid, lane, wave;
    int vcu, G;
    const float* in[28]; float* out;
    bf16 *Wgu1, *Wdn1, *Win, *Wout, *Wgu2, *Wdn2;
    bf16 *XN, *H, *OAB; float* Fm;
};
enum { I_X = 0, I_F1PRE, I_F1POST, I_F1GU, I_F1DN, I_MPRE, I_MPOST, I_WIN, I_MU, I_WUP, I_W0, I_AUP, I_A0, I_GUP, I_KK, I_KA, I_RK, I_GNW, I_GNB, I_CDW, I_CB, I_CLW, I_CLB, I_WOUT, I_F2PRE, I_F2POST, I_F2GU, I_F2DN };

__device__ __forceinline__ float wave_sum(float v) {
#pragma unroll
    for (int o = 1; o < 64; o <<= 1) v += __shfl_xor(v, o);
    return v;
}
__device__ __forceinline__ float bf2f(bf16 v) { return __uint_as_float(((unsigned)v) << 16); }
__device__ __forceinline__ float sigm(float x) { return 1.0f / (1.0f + __expf(-x)); }

__device__ __forceinline__ void p0_transpose_item(const float* W, int K, int N, bf16* WT, int gu, LAS float* scr, int item, int lane) {
    const int nblk = N / 32, kb = item / nblk, nb = item % nblk, k0 = 64 * kb, n0 = 32 * nb;
    int r0 = n0;
    if (gu) { const int up = n0 >= DFF ? 1 : 0, nn = n0 - up * DFF; r0 = (nn >> 7) * 256 + up * 128 + (nn & 127); }
#pragma unroll 8
    for (int i = 0; i < 32; ++i) { const int kk = 2 * i + (lane >> 5); scr[kk * 33 + (lane & 31)] = W[(size_t)(k0 + kk) * N + n0 + (lane & 31)]; }
    LDS_WAIT(); asm volatile("" ::: "memory");
    const int c = lane & 7;
#pragma unroll
    for (int j = 0; j < 4; ++j) { const int n = (lane >> 3) + 8 * j; const LAS float* s = scr + (8 * c) * 33 + n;
        v4u o; o.x = pk2(s[0 * 33], s[1 * 33]); o.y = pk2(s[2 * 33], s[3 * 33]); o.z = pk2(s[4 * 33], s[5 * 33]); o.w = pk2(s[6 * 33], s[7 * 33]);
        *(GAS v4u*)(WT + (size_t)(r0 + n) * K + k0 + 8 * c) = o; }
    LDS_WAIT(); asm volatile("" ::: "memory");
}
__device__ __forceinline__ void rms_row_to_bf16(Frame& F, const float* xrow, const float* g, bf16* orow) {
    const GAS f32x4* xr = (const GAS f32x4*)xrow + F.lane; const GAS f32x4* gr = (const GAS f32x4*)g + F.lane;
    f32x4 v[4]; float s = 0.f;
#pragma unroll
    for (int j = 0; j < 4; ++j) { v[j] = xr[64 * j]; s += (v[j].x * v[j].x + v[j].y * v[j].y) + (v[j].z * v[j].z + v[j].w * v[j].w); }
    const float r = 1.0f / sqrtf(wave_sum(s) * (1.f / D) + RMS_EPS);
    GAS unsigned long long* o8 = (GAS unsigned long long*)orow + F.lane;
#pragma unroll
    for (int j = 0; j < 4; ++j) { const f32x4 gg = gr[64 * j]; o8[64 * j] = (unsigned long long)pk2(v[j].x * r * gg.x, v[j].y * r * gg.y) | ((unsigned long long)pk2(v[j].z * r * gg.z, v[j].w * r * gg.w) << 32); }
}
__device__ __forceinline__ void p0_prologue(Frame& F) {
    LAS float* scr = (LAS float*)(F.lds + RING_OFF + F.wave * 16384);
    const int gw = F.vcu * NWAVES + F.wave, NGW = F.G * NWAVES;
    constexpr int I_GU = (D / 64) * (NGU / 32), I_DN = (DFF / 64) * (D / 32), I_IN = (D / 64) * (DIN / 32), I_OUT = (D / 64) * (D / 32);
    constexpr int NITEMS = 2 * I_GU + 2 * I_DN + I_IN + I_OUT;
    for (int it = gw; it < NITEMS; it += NGW) {
        int r = it;
        if (r < I_GU) { p0_transpose_item(F.in[I_F1GU], D, NGU, F.Wgu1, 1, scr, r, F.lane); continue; } r -= I_GU;
        if (r < I_GU) { p0_transpose_item(F.in[I_F2GU], D, NGU, F.Wgu2, 1, scr, r, F.lane); continue; } r -= I_GU;
        if (r < I_DN) { p0_transpose_item(F.in[I_F1DN], DFF, D, F.Wdn1, 0, scr, r, F.lane); continue; } r -= I_DN;
        if (r < I_DN) { p0_transpose_item(F.in[I_F2DN], DFF, D, F.Wdn2, 0, scr, r, F.lane); continue; } r -= I_DN;
        if (r < I_IN) { p0_transpose_item(F.in[I_WIN], D, DIN, F.Win, 0, scr, r, F.lane); continue; } r -= I_IN;
        p0_transpose_item(F.in[I_WOUT], D, D, F.Wout, 0, scr, r, F.lane);
    }
    for (int m = gw; m < M; m += NGW) rms_row_to_bf16(F, F.in[I_X] + (size_t)m * D, F.in[I_F1PRE], F.XN + (size_t)m * D);
}
__device__ __forceinline__ void norm_pass(Frame& F, const float* Fm, const float* base, float* out, const float* gpost, float scale, const float* gpre, bf16* xn) {
    const int gw = F.vcu * NWAVES + F.wave, NGW = F.G * NWAVES;
    for (int m = gw; m < M; m += NGW) {
        const GAS f32x4* fr = (const GAS f32x4*)(Fm + (size_t)m * D) + F.lane; const GAS f32x4* br = (const GAS f32x4*)(base + (size_t)m * D) + F.lane;
        const GAS f32x4* gp = (const GAS f32x4*)gpost + F.lane;
        f32x4 f[4], o[4]; float s = 0.f;
#pragma unroll
        for (int j = 0; j < 4; ++j) { f[j] = fr[64 * j]; o[j] = br[64 * j]; s += (f[j].x * f[j].x + f[j].y * f[j].y) + (f[j].z * f[j].z + f[j].w * f[j].w); }
        const float r = scale / sqrtf(wave_sum(s) * (1.f / D) + RMS_EPS);
        float s2 = 0.f;
#pragma unroll
        for (int j = 0; j < 4; ++j) { const f32x4 g = gp[64 * j]; o[j] = o[j] + f[j] * r * g; s2 += (o[j].x * o[j].x + o[j].y * o[j].y) + (o[j].z * o[j].z + o[j].w * o[j].w); }
        GAS f32x4* orow = (GAS f32x4*)(out + (size_t)m * D) + F.lane;
#pragma unroll
        for (int j = 0; j < 4; ++j) orow[64 * j] = o[j];
        if (xn) {
            const float r2 = 1.0f / sqrtf(wave_sum(s2) * (1.f / D) + RMS_EPS);
            const GAS f32x4* gq = (const GAS f32x4*)gpre + F.lane;
            GAS unsigned long long* o8 = (GAS unsigned long long*)(xn + (size_t)m * D) + F.lane;
#pragma unroll
            for (int j = 0; j < 4; ++j) { const f32x4 gg = gq[64 * j]; o8[64 * j] = (unsigned long long)pk2(o[j].x * r2 * gg.x, o[j].y * r2 * gg.y) | ((unsigned long long)pk2(o[j].z * r2 * gg.z, o[j].w * r2 * gg.w) << 32); }
        }
    }
}

__device__ __forceinline__ void conv_unit(Frame& F, const bf16* P, int unit) {
    const int b = unit / (SEQ / 32), t0 = (unit % (SEQ / 32)) * 32, c = F.tid;
    LAS float* sG = (LAS float*)(F.lds + RING_OFF);
    LAS float* sRed = sG + 62 * 512;
    for (int rr = 0; rr < 62; ++rr) { const int t = t0 - 30 + rr; float v = 0.f;
        if (t >= 0) { const bf16* pr = P + (size_t)(b * SEQ + t) * DIN + DSHIFT; const float a = bf2f(pr[c]), g = bf2f(pr[DCV + c]); v = a * sigm(g); }
        sG[rr * 512 + c] = v; }
    float w[CONVW];
#pragma unroll
    for (int j = 0; j < CONVW; ++j) w[j] = F.in[I_CDW][j * DCV + c];
    const float cb = F.in[I_CB][c], lw = F.in[I_CLW][c], lb = F.in[I_CLB][c];
#pragma unroll 1
    for (int tt = 0; tt < 32; ++tt) { float a = cb;
#pragma unroll
        for (int j = 0; j < CONVW; ++j) a += w[j] * sG[(tt + j) * 512 + c];
        sG[tt * 512 + c] = a;
        const float s = wave_sum(a); if (F.lane == 0) sRed[tt * 8 + F.wave] = s; }
    __syncthreads();
#pragma unroll 1
    for (int tt = 0; tt < 32; ++tt) { float s = 0.f;
#pragma unroll
        for (int k = 0; k < 8; ++k) s += sRed[tt * 8 + k];
        sG[tt * 512 + c] -= s * (1.f / DCV); }
    __syncthreads();
#pragma unroll 1
    for (int tt = 0; tt < 32; ++tt) { const float d = sG[tt * 512 + c]; const float s = wave_sum(d * d); if (F.lane == 0) sRed[tt * 8 + F.wave] = s; }
    __syncthreads();
#pragma unroll 1
    for (int tt = 0; tt < 32; ++tt) { float s = 0.f;
#pragma unroll
        for (int k = 0; k < 8; ++k) s += sRed[tt * 8 + k];
        const float v = sG[tt * 512 + c] * (1.0f / sqrtf(s * (1.f / DCV) + LN_EPS)) * lw + lb;
        F.OAB[(size_t)(b * SEQ + t0 + tt) * D + DRW + c] = (bf16)f2bf(v * sigm(v)); }
    __syncthreads();
}

__device__ __forceinline__ float dpp_add(float v, const int ctrl_sel) {
    int r;
    if (ctrl_sel == 0) r = __builtin_amdgcn_update_dpp(0, __builtin_bit_cast(int, v), 0xB1, 0xF, 0xF, true);
    else if (ctrl_sel == 1) r = __builtin_amdgcn_update_dpp(0, __builtin_bit_cast(int, v), 0x4E, 0xF, 0xF, true);
    else r = __builtin_amdgcn_update_dpp(0, __builtin_bit_cast(int, v), 0x141, 0xF, 0xF, true);
    return v + __builtin_bit_cast(float, r);
}
__device__ __forceinline__ float red8(float v) { v = dpp_add(v, 0); v = dpp_add(v, 1); v = dpp_add(v, 2); return v; }

__device__ __forceinline__ void rwkv_seq(Frame& F, const bf16* P, int bh) {
    const int b = bh >> 3, h = bh & 7, tid = F.tid, lane = F.lane, wv = F.wave;
    LAS float* sR = (LAS float*)(F.lds + RING_OFF); LAS float* sK = sR + 2048; LAS float* sV = sK + 2048; LAS float* sW = sV + 2048; LAS float* sA = sW + 2048;
    LAS float* sG = sA + 2048; LAS float* sKK = sG + 2048; LAS float* sY = sKK + 2048; LAS float* sXG = sY + 2048; LAS float* sBon = sXG + 4096;
    const int hj = h * 64 + lane;
    const float w0j = F.in[I_W0][hj], a0j = F.in[I_A0][hj], kkj = F.in[I_KK][hj], kaj = F.in[I_KA][hj], rkj = F.in[I_RK][hj], gnwj = F.in[I_GNW][hj], gnbj = F.in[I_GNB][hj];
    const int colg[7] = {h * 64, DRW + h * 64, 2 * DRW + h * 64, 3 * DRW, 3 * DRW + 64, 3 * DRW + 128, 3 * DRW + 192};
    float mu[7];
#pragma unroll
    for (int g = 0; g < 7; ++g) mu[g] = F.in[I_MU][colg[g] + lane];
    const float* wup = F.in[I_WUP] + hj; const float* aup = F.in[I_AUP] + hj; const float* gup = F.in[I_GUP] + hj;
    float st[8];
#pragma unroll
    for (int j = 0; j < 8; ++j) st[j] = 0.f;
    const int ri = tid >> 3, c0 = (tid & 7) * 8, tb = wv * 4;
    for (int stage = 0; stage < SEQ / 32; ++stage) {
        const int t0 = stage * 32;
#pragma unroll
        for (int g = 0; g < 7; ++g) {
            for (int tt = wv; tt < 32; tt += 8) {
                const size_t row = (size_t)b * SEQ + t0 + tt;
                const float cur = bf2f(P[row * DIN + colg[g] + lane]);
                const float prev = (t0 + tt > 0) ? bf2f(P[(row - 1) * DIN + colg[g] + lane]) : 0.f;
                float v = cur + (prev - cur) * mu[g];
                if (g == 0) sR[tt * 64 + lane] = v;
                else if (g == 1) sK[tt * 64 + lane] = v;
                else if (g == 2) sV[tt * 64 + lane] = v;
                else if (g == 3) sW[tt * 64 + lane] = tanhf(v);
                else if (g == 4) sA[tt * 64 + lane] = v;
                else sXG[tt * 128 + (g - 5) * 64 + lane] = sigm(v);
            }
        }
        __syncthreads();
        float aD[4], aA[4], aG[4];
#pragma unroll
        for (int i = 0; i < 4; ++i) { aD[i] = w0j; aA[i] = a0j; aG[i] = 0.f; }
        for (int k = 0; k < 64; ++k) { const float wu = wup[k * DRW], au = aup[k * DRW];
#pragma unroll
            for (int i = 0; i < 4; ++i) { aD[i] += sW[(tb + i) * 64 + k] * wu; aA[i] += sA[(tb + i) * 64 + k] * au; } }
        for (int k = 0; k < 128; ++k) { const float gu = gup[k * DRW];
#pragma unroll
            for (int i = 0; i < 4; ++i) aG[i] += sXG[(tb + i) * 128 + k] * gu; }
        __syncthreads();
#pragma unroll
        for (int i = 0; i < 4; ++i) { const int t = tb + i;
            const float dec = __expf(-DECAY_SCALE * sigm(aD[i])), a = sigm(aA[i]);
            const float kraw = sK[t * 64 + lane], kkr = kraw * kkj; const float ss = wave_sum(kkr * kkr);
            const float kk = kkr * (1.0f / sqrtf(fmaxf(ss, 1e-12f)));
            const float kp = kraw * (1.0f + (a - 1.0f) * kaj);
            const float bon = wave_sum(sR[t * 64 + lane] * kp * rkj);
            sW[t * 64 + lane] = dec; sA[t * 64 + lane] = a; sG[t * 64 + lane] = aG[i]; sKK[t * 64 + lane] = kk; sK[t * 64 + lane] = kp; if (lane == 0) sBon[t] = bon; }
        __syncthreads();
        for (int t = 0; t < 32; ++t) {
            const f32x4 k0 = *(const LAS f32x4*)(sKK + t * 64 + c0), k1 = *(const LAS f32x4*)(sKK + t * 64 + c0 + 4);
            const f32x4 a0 = *(const LAS f32x4*)(sA + t * 64 + c0), a1 = *(const LAS f32x4*)(sA + t * 64 + c0 + 4);
            const f32x4 w0 = *(const LAS f32x4*)(sW + t * 64 + c0), w1 = *(const LAS f32x4*)(sW + t * 64 + c0 + 4);
            const f32x4 q0 = *(const LAS f32x4*)(sK + t * 64 + c0), q1 = *(const LAS f32x4*)(sK + t * 64 + c0 + 4);
            const f32x4 r0 = *(const LAS f32x4*)(sR + t * 64 + c0), r1 = *(const LAS f32x4*)(sR + t * 64 + c0 + 4);
            const float v = sV[t * 64 + ri];
            const float kkv[8] = {k0[0], k0[1], k0[2], k0[3], k1[0], k1[1], k1[2], k1[3]};
            const float av[8] = {a0[0], a0[1], a0[2], a0[3], a1[0], a1[1], a1[2], a1[3]};
            const float wv8[8] = {w0[0], w0[1], w0[2], w0[3], w1[0], w1[1], w1[2], w1[3]};
            const float kv[8] = {q0[0], q0[1], q0[2], q0[3], q1[0], q1[1], q1[2], q1[3]};
            const float rv[8] = {r0[0], r0[1], r0[2], r0[3], r1[0], r1[1], r1[2], r1[3]};
            float sz = 0.f;
#pragma unroll
            for (int j = 0; j < 8; ++j) sz -= st[j] * kkv[j];
            sz = red8(sz);
            float y = 0.f;
#pragma unroll
            for (int j = 0; j < 8; ++j) { st[j] = st[j] * wv8[j] + sz * (kkv[j] * av[j]) + v * kv[j]; y += st[j] * rv[j]; }
            y = red8(y);
            if ((tid & 7) == 0) sY[t * 64 + ri] = y;
        }
        __syncthreads();
#pragma unroll
        for (int i = 0; i < 4; ++i) { const int t = tb + i;
            const float y = sY[t * 64 + lane]; const float mean = wave_sum(y) * (1.f / 64.f); const float d = y - mean; const float var = wave_sum(d * d) * (1.f / 64.f);
            float yn = d * (1.0f / sqrtf(var + GN_EPS)) * gnwj + gnbj;
            yn += sBon[t] * sV[t * 64 + lane];
            F.OAB[((size_t)b * SEQ + t0 + t) * D + hj] = (bf16)f2bf(yn * sG[t * 64 + lane]); }
        __syncthreads();
    }
}

struct Args { const float* in[28]; float* out; unsigned char* ws; int ph_lo, ph_hi; };
__global__ void __launch_bounds__(NWAVES * 64, 2) mk_fwd(Args args) {
    extern __shared__ __attribute__((aligned(16))) unsigned char lds[];
    Frame F;
    F.lds = (LAS unsigned char*)lds;
    F.MISC = (volatile LAS unsigned*)(F.lds + MISC_OFF);
    F.tid = threadIdx.x; F.lane = F.tid & 63; F.wave = __builtin_amdgcn_readfirstlane(F.tid >> 6);
    F.G = gridDim.x; { const int bx = blockIdx.x; F.vcu = (F.G % 8 == 0) ? (bx % 8) * (F.G / 8) + bx / 8 : bx; }
    unsigned char* ws = args.ws;
    F.ctl = (gu32*)(ws + WS_CTL);
#pragma unroll
    for (int i = 0; i < 28; ++i) F.in[i] = args.in[i];
    F.out = args.out;
    F.Wgu1 = (bf16*)(ws + WS_WGU1); F.Wdn1 = (bf16*)(ws + WS_WDN1); F.Win = (bf16*)(ws + WS_WIN); F.Wout = (bf16*)(ws + WS_WOUT); F.Wgu2 = (bf16*)(ws + WS_WGU2); F.Wdn2 = (bf16*)(ws + WS_WDN2);
    F.XN = (bf16*)(ws + WS_XN); F.H = (bf16*)(ws + WS_H); F.OAB = (bf16*)(ws + WS_OAB); F.Fm = (float*)(ws + WS_F);
    for (int u = F.tid; u < (LDS_BYTES - LDSCTL_OFF) / 4; u += NWAVES * 64) ((LAS unsigned*)(F.lds + LDSCTL_OFF))[u] = 0u;
    __syncthreads();
    XcdBarrier bar; bar.bar = (unsigned*)(F.ctl + CW_BAR); bar.x = 0; bar.st = nullptr;
    if (MK_ONE_LAUNCH) bar = xcd_barrier_post((unsigned*)(F.ctl + CW_BAR), F.MISC + 8);
    const int lo = args.ph_lo, hi = args.ph_hi;
#ifndef PH_MASK
#define PH_MASK 0xFFFF
#endif
#define IN(k) (((PH_MASK >> (k)) & 1) && lo <= (k) && (k) < hi)
#define SEAM(k) do { if (IN(k) && IN((k) + 1)) xcd_barrier(bar); } while (0)

    if (IN(0)) { p0_prologue(F); } SEAM(0);
    if (IN(1)) { pg8::Gemm g{F.XN, F.Wgu1, M, NGU, D}; pg8::StaticOrder S; S.init(M, NGU, F.G, (int)blockIdx.x); pg8::EpiSwiGLU E{F.H, DFF};
        pg8::gemm_phase<pg8::EpiSwiGLU, pg8::StaticOrder, true, true>(F.lds + RING_OFF, g, S, E); } SEAM(1);
    if (IN(2)) { pg8::Gemm g{F.H, F.Wdn1, M, D, DFF}; pg8::StaticOrder S; S.init(M, D, F.G, (int)blockIdx.x); pg8::EpiF32 E{F.Fm, D};
        pg8::gemm_phase<pg8::EpiF32, pg8::StaticOrder, true, true>(F.lds + RING_OFF, g, S, E); } SEAM(2);
    if (IN(3)) { norm_pass(F, F.Fm, F.in[I_X], F.out, F.in[I_F1POST], 0.5f, F.in[I_MPRE], F.XN); } SEAM(3);
    if (IN(4)) { pg8::Gemm g{F.XN, F.Win, M, DIN, D}; pg8::StaticOrder S; S.init(M, DIN, F.G, (int)blockIdx.x); pg8::EpiBf16 E{F.H, DIN};
        pg8::gemm_phase<pg8::EpiBf16, pg8::StaticOrder, true, true>(F.lds + RING_OFF, g, S, E); } SEAM(4);
    if (IN(5)) {
        if ((int)blockIdx.x < BATCH * NH) rwkv_seq(F, F.H, (int)blockIdx.x);
        else for (int u = (int)blockIdx.x - BATCH * NH; u < M / 32; u += F.G - BATCH * NH) conv_unit(F, F.H, u);
    } SEAM(5);
    if (IN(6)) { pg8::Gemm g{F.OAB, F.Wout, M, D, D}; pg8::StaticOrder S; S.init(M, D, F.G, (int)blockIdx.x); pg8::EpiF32 E{F.Fm, D};
        pg8::gemm_phase<pg8::EpiF32, pg8::StaticOrder, true, true>(F.lds + RING_OFF, g, S, E); } SEAM(6);
    if (IN(7)) { norm_pass(F, F.Fm, F.out, F.out, F.in[I_MPOST], 1.0f, F.in[I_F2PRE], F.XN); } SEAM(7);
    if (IN(8)) { pg8::Gemm g{F.XN, F.Wgu2, M, NGU, D}; pg8::StaticOrder S; S.init(M, NGU, F.G, (int)blockIdx.x); pg8::EpiSwiGLU E{F.H, DFF};
        pg8::gemm_phase<pg8::EpiSwiGLU, pg8::StaticOrder, true, true>(F.lds + RING_OFF, g, S, E); } SEAM(8);
    if (IN(9)) { pg8::Gemm g{F.H, F.Wdn2, M, D, DFF}; pg8::StaticOrder S; S.init(M, D, F.G, (int)blockIdx.x); pg8::EpiF32 E{F.Fm, D};
        pg8::gemm_phase<pg8::EpiF32, pg8::StaticOrder, true, true>(F.lds + RING_OFF, g, S, E); } SEAM(9);
    if (IN(10)) { norm_pass(F, F.Fm, F.out, F.out, F.in[I_F2POST], 0.5f, nullptr, nullptr); }
#undef IN
#undef SEAM
}

extern "C" void kernel_launch(void* const* d_in, const int* in_sizes, int n_in, void* d_out, int out_size, void* d_ws, size_t ws_size, hipStream_t stream) {
    static int grid = 0;
    if (grid == 0) {
        if (n_in != 28 || in_sizes[0] != M * D || out_size != M * D || ws_size < WS_END) { fprintf(stderr, "kernel_launch: unexpected shapes (n_in %d, in0 %d, out %d, ws %zu); nothing launched\n", n_in, n_in > 0 ? in_sizes[0] : -1, out_size, ws_size); grid = -1; return; }
        int dev = 0, cus = 0, per_cu = 0;
        if (hipGetDevice(&dev) != hipSuccess || hipDeviceGetAttribute(&cus, hipDeviceAttributeMultiprocessorCount, dev) != hipSuccess) { grid = -1; return; }
        if (hipFuncSetAttribute((const void*)mk_fwd, hipFuncAttributeMaxDynamicSharedMemorySize, LDS_BYTES) != hipSuccess) { fprintf(stderr, "kernel_launch: hipFuncSetAttribute failed\n"); grid = -1; return; }
        if (hipOccupancyMaxActiveBlocksPerMultiprocessor(&per_cu, (const void*)mk_fwd, NWAVES * 64, LDS_BYTES) != hipSuccess || per_cu < 1) { fprintf(stderr, "kernel_launch: occupancy query says %d blocks per CU; nothing launched\n", per_cu); (void)hipGetLastError(); grid = -1; return; }
        grid = cus;
    }
    if (grid < 0) return;
    if (hipMemsetAsync((char*)d_ws + WS_CTL, 0, CTL_ZERO_BYTES, stream) != hipSuccess) { fprintf(stderr, "kernel_launch: hipMemsetAsync failed\n"); return; }
    Args a{};
    for (int i = 0; i < 28; ++i) a.in[i] = (const float*)d_in[i];
    a.out = (float*)d_out; a.ws = (unsigned char*)d_ws;
#if MK_ONE_LAUNCH
    a.ph_lo = 0; a.ph_hi = N_PHASES;
    hipLaunchKernelGGL(mk_fwd, dim3(grid), dim3(NWAVES * 64), LDS_BYTES, stream, a);
#else
    for (int p = 0; p < N_PHASES; ++p) { a.ph_lo = p; a.ph_hi = p + 1; hipLaunchKernelGGL(mk_fwd, dim3(grid), dim3(NWAVES * 64), LDS_BYTES, stream, a); }
#endif
    const hipError_t le = hipPeekAtLastError();
    if (le != hipSuccess) fprintf(stderr, "kernel_launch: launch failed: %s\n", hipGetErrorName(le));
}
```

```cpp
#include <hip/hip_runtime.h>
#include <cstdio>
#include <cstdint>
namespace pg8 {
#define PG8_LAS __attribute__((address_space(3)))
typedef unsigned short bf16_t;
typedef short bf16x8 __attribute__((ext_vector_type(8)));
typedef float f32x4 __attribute__((ext_vector_type(4)));
typedef unsigned u32x4 __attribute__((ext_vector_type(4)));
constexpr int BM = 256, BK = 64, HALF = 128, HTB = HALF * BK * 2  , STAGE_BYTES = 8 * HTB, NXCD = 8, WGM = 8;

__host__ __device__ __forceinline__ int lds_byte(int r, int c) { const int st = (r >> 4) * 2 + (c >> 5), rr = r & 15, cc = c & 31, ob = rr * 64 + cc * 2; return st * 1024 + (ob ^ (((ob >> 9) & 1) << 5)); }
__host__ __device__ __forceinline__ void stage_rc(int b, int& R, int& C) { const int st = b / 1024, sb = b % 1024, swz = sb ^ (((sb >> 9) & 1) << 5); R = (st >> 1) * 16 + swz / 64; C = (st & 1) * 32 + (swz % 64) / 2; }
__host__ __device__ __forceinline__ int perm32(int rho) { const int n = rho >> 4, i = rho & 15; return 8 * (i >> 2) + 4 * n + (i & 3); }

struct Unit { int pm, pn; };
struct Gemm { const bf16_t* A; const bf16_t* Bt; int M, N, K; };

struct StaticOrder {
    int nM, nN, nwg, G, c;
    __host__ __device__ void init(int M, int N, int G_, int c_) { nM = M / BM; nN = N / BM; nwg = nM * nN; G = G_; c = c_; }
    __host__ __device__ bool next(int i, Unit& u) const {
        const long L = (long)i * G + c; if (L >= nwg) return false;
        int wgid = (int)L; { const int q = nwg / NXCD, r = nwg % NXCD, xcd = wgid % NXCD, off = wgid / NXCD; wgid = (xcd < r ? xcd * (q + 1) : r * (q + 1) + (xcd - r) * q) + off; }
        const int nig = WGM * nN, gid = wgid / nig, fm = gid * WGM, gsz = (nM - fm) < WGM ? (nM - fm) : WGM;
        u.pm = fm + ((wgid % nig) % gsz); u.pn = (wgid % nig) / gsz; return true;
    }
    __device__ __forceinline__ void a_ready(const Unit&) const {}
    __device__ __forceinline__ void done(const Unit&) const {}
};
__device__ __forceinline__ unsigned cvt_pk_bf16(float lo, float hi) { unsigned r; asm volatile("v_cvt_pk_bf16_f32 %0, %1, %2" : "=v"(r) : "v"(lo), "v"(hi)); return r; }
typedef float f32x2 __attribute__((ext_vector_type(2)));
__device__ __forceinline__ float silu_mul(float g, float u) { const float e = __builtin_amdgcn_exp2f(g * -1.44269504f); return g * __builtin_amdgcn_rcpf(1.0f + e) * u; }

struct EpiBf16 {
    static constexpr bool PERM = true, AFTER_DRAIN = false;
    bf16_t* O; int ldc;
    __device__ __forceinline__ void operator()(const f32x4 (&acc)[2][2][4][2], const Unit& u, int wr, int wc, int fr, int fq) const {
        const int row0 = u.pm * BM + wr * 64 + fr; const int col0 = u.pn * BM + wc * 32 + 8 * fq;
#pragma unroll
        for (int ai = 0; ai < 2; ++ai)
#pragma unroll
            for (int m = 0; m < 4; ++m) { bf16_t* rowp = O + (size_t)(row0 + ai * HALF + m * 16) * ldc + col0;
#pragma unroll
                for (int bj = 0; bj < 2; ++bj) { const f32x4 v0 = acc[ai][bj][m][0], v1 = acc[ai][bj][m][1];
                    u32x4 w; w.x = cvt_pk_bf16(v0[0], v0[1]); w.y = cvt_pk_bf16(v0[2], v0[3]); w.z = cvt_pk_bf16(v1[0], v1[1]); w.w = cvt_pk_bf16(v1[2], v1[3]);
                    *(u32x4*)(rowp + bj * HALF) = w; } }
    }
};
struct EpiSwiGLU {
    static constexpr bool PERM = true, AFTER_DRAIN = false;
    bf16_t* H; int ldh;
    __device__ __forceinline__ void operator()(const f32x4 (&acc)[2][2][4][2], const Unit& u, int wr, int wc, int fr, int fq) const {
        const int row0 = u.pm * BM + wr * 64 + fr; const int col0 = u.pn * HALF + wc * 32 + 8 * fq;
#pragma unroll
        for (int ai = 0; ai < 2; ++ai)
#pragma unroll
            for (int m = 0; m < 4; ++m) { bf16_t* rowp = H + (size_t)(row0 + ai * HALF + m * 16) * ldh + col0;
                const f32x4 g0 = acc[ai][0][m][0], g1 = acc[ai][0][m][1], u0 = acc[ai][1][m][0], u1 = acc[ai][1][m][1];
                u32x4 w; w.x = cvt_pk_bf16(silu_mul(g0[0], u0[0]), silu_mul(g0[1], u0[1])); w.y = cvt_pk_bf16(silu_mul(g0[2], u0[2]), silu_mul(g0[3], u0[3]));
                w.z = cvt_pk_bf16(silu_mul(g1[0], u1[0]), silu_mul(g1[1], u1[1])); w.w = cvt_pk_bf16(silu_mul(g1[2], u1[2]), silu_mul(g1[3], u1[3]));
                *(u32x4*)rowp = w; }
    }
};
struct EpiF32 {
    static constexpr bool PERM = false, AFTER_DRAIN = false;
    float* C; int ldc;
    __device__ __forceinline__ void operator()(const f32x4 (&acc)[2][2][4][2], const Unit& u, int wr, int wc, int fr, int fq) const {
        const int row0 = u.pm * BM + wr * 64 + fr, col0 = u.pn * BM + wc * 32 + 4 * fq;
#pragma unroll
        for (int ai = 0; ai < 2; ++ai)
#pragma unroll
            for (int m = 0; m < 4; ++m) { float* rowp = C + (size_t)(row0 + ai * HALF + m * 16) * ldc + col0;
#pragma unroll
                for (int bj = 0; bj < 2; ++bj)
#pragma unroll
                    for (int n = 0; n < 2; ++n) *(f32x4*)(rowp + bj * HALF + n * 16) = acc[ai][bj][m][n]; }
    }
};
template <class Epi, class Sched, bool ALIGN_EPI = false, bool SP2 = false>
__device__ __forceinline__ void gemm_phase(PG8_LAS unsigned char* lds, const Gemm g, const Sched& S, const Epi& E) {
    const int tid = threadIdx.x, wid = __builtin_amdgcn_readfirstlane(tid >> 6), lane = tid & 63, wr = wid >> 2, wc = wid & 3, fr = lane & 15, fq = lane >> 4;
    const int K = g.K, nt = K / BK;
    unsigned voffA[2], voffB[2];
#pragma unroll
    for (int i = 0; i < 2; ++i) { int R, C; stage_rc(tid * 16 + i * 8192, R, C); const int Rb = Epi::PERM ? ((R & ~31) + perm32(R & 31)) : R;
        voffA[i] = (unsigned)(R * K + C) * 2u; voffB[i] = (unsigned)(Rb * K + C) * 2u; }
    const size_t kstep = (size_t)(BK * 2);
    const size_t hstep = (size_t)HALF * K * 2;
    const size_t tstep = 2 * hstep;
    const unsigned ldsw = (unsigned)wid * 1024u;
    const int aoff = lds_byte(wr * 64 + fr, fq * 8), boff = lds_byte(wc * 32 + fr, fq * 8);
#define PG8_SA(b, h) (((b) * 2 + (h)) * HTB)
#define PG8_SB(b, h) ((4 + (b) * 2 + (h)) * HTB)
#define PG8_STAGE(bufoff, gbase, voff) do { _Pragma("unroll") for (int _i = 0; _i < 2; ++_i) \
        __builtin_amdgcn_global_load_lds((const unsigned*)((const char*)(gbase) + (voff)[_i]), (PG8_LAS unsigned*)(lds + (bufoff) + ldsw + _i * 8192), 16, 0, 0); } while (0)
#define PG8_LDA(dst, b, h) do { _Pragma("unroll") for (int m = 0; m < 4; ++m) _Pragma("unroll") for (int k = 0; k < 2; ++k) dst[m][k] = *(const PG8_LAS bf16x8*)(lds + PG8_SA(b, h) + aoff + m * 2048 + k * 1024); } while (0)
#define PG8_LDB(dst, b, h) do { _Pragma("unroll") for (int n = 0; n < 2; ++n) _Pragma("unroll") for (int k = 0; k < 2; ++k) dst[n][k] = *(const PG8_LAS bf16x8*)(lds + PG8_SB(b, h) + boff + n * 2048 + k * 1024); } while (0)
#define PG8_MMA(ai, bj, At, Bt) do { __builtin_amdgcn_s_setprio(1); _Pragma("unroll") for (int m = 0; m < 4; ++m) _Pragma("unroll") for (int n = 0; n < 2; ++n) _Pragma("unroll") for (int k = 0; k < 2; ++k) \
        acc[ai][bj][m][n] = __builtin_amdgcn_mfma_f32_16x16x32_bf16(Bt[n][k], At[m][k], acc[ai][bj][m][n], 0, 0, 0); __builtin_amdgcn_s_setprio(0); } while (0)
#define PG8_WAIT_V(n) asm volatile("s_waitcnt vmcnt(" #n ")" ::: "memory")
#define PG8_WAIT_L(n) asm volatile("s_waitcnt lgkmcnt(" #n ")" ::: "memory")
#define PG8_BAR __builtin_amdgcn_s_barrier()
#define PG8_SCHED __builtin_amdgcn_sched_barrier(0)
    Unit cur, nxt; int ui = 0;
    if (!S.next(0, cur)) return;
    f32x4 acc[2][2][4][2];
#pragma unroll
    for (int a = 0; a < 2; ++a)
#pragma unroll
        for (int b = 0; b < 2; ++b)
#pragma unroll
            for (int m = 0; m < 4; ++m)
#pragma unroll
                for (int n = 0; n < 2; ++n) acc[a][b][m][n] = (f32x4){0.f, 0.f, 0.f, 0.f};
    bf16x8 At[4][2], B0[2][2], B1[2][2];
    const char* cA = (const char*)g.A + (size_t)cur.pm * tstep; const char* cB = (const char*)g.Bt + (size_t)cur.pn * tstep;
    S.a_ready(cur);
    if constexpr (SP2) {
        PG8_STAGE(PG8_SB(0, 0), cB, voffB); PG8_STAGE(PG8_SB(0, 1), cB + hstep, voffB); PG8_STAGE(PG8_SA(0, 0), cA, voffA); PG8_STAGE(PG8_SA(0, 1), cA + hstep, voffA);
        if (wr == 1) PG8_BAR;
        PG8_WAIT_V(2); PG8_BAR;
        PG8_STAGE(PG8_SB(1, 0), cB + kstep, voffB); PG8_STAGE(PG8_SA(1, 0), cA + kstep, voffA); PG8_STAGE(PG8_SB(1, 1), cB + hstep + kstep, voffB);
        PG8_WAIT_V(6); PG8_BAR;
    } else {
        PG8_STAGE(PG8_SB(0, 0), cB, voffB); PG8_STAGE(PG8_SA(0, 0), cA, voffA); PG8_STAGE(PG8_SB(0, 1), cB + hstep, voffB); PG8_STAGE(PG8_SA(0, 1), cA + hstep, voffA);
        if (wr == 1) PG8_BAR;
        PG8_WAIT_V(4); PG8_BAR;
        PG8_STAGE(PG8_SB(1, 0), cB + kstep, voffB); PG8_STAGE(PG8_SA(1, 0), cA + kstep, voffA); PG8_STAGE(PG8_SB(1, 1), cB + hstep + kstep, voffB);
        PG8_WAIT_V(6); PG8_BAR;
    }
    for (;;) {
        const bool has_next = S.next(ui + 1, nxt);
        const char* nA = has_next ? (const char*)g.A + (size_t)nxt.pm * tstep : cA; const char* nB = has_next ? (const char*)g.Bt + (size_t)nxt.pn * tstep : cB;
        for (int t = 0; t < nt; t += 2) {
            const bool last = (t == nt - 2);
            const char* a1 = cA + (size_t)(t + 1) * kstep;
            const char* a2 = last ? nA : cA + (size_t)(t + 2) * kstep; const char* b2 = last ? nB : cB + (size_t)(t + 2) * kstep;
            const char* a3 = a2 + kstep; const char* b3 = b2 + kstep;
            if (last && has_next) S.a_ready(nxt);
            if constexpr (SP2) {
            PG8_LDB(B0, 0, 0); PG8_LDB(B1, 0, 1); PG8_SCHED; PG8_LDA(At, 0, 0); PG8_STAGE(PG8_SA(1, 1), a1 + hstep, voffA);
            PG8_WAIT_V(8); PG8_WAIT_L(0); PG8_BAR; PG8_MMA(0, 0, At, B0); PG8_MMA(0, 1, At, B1); PG8_BAR; PG8_SCHED;
            PG8_LDA(At, 0, 1); PG8_STAGE(PG8_SB(0, 0), b2, voffB); PG8_STAGE(PG8_SB(0, 1), b2 + hstep, voffB); PG8_STAGE(PG8_SA(0, 0), a2, voffA);
            PG8_WAIT_V(8); PG8_WAIT_L(0); PG8_BAR; PG8_MMA(1, 0, At, B0); PG8_MMA(1, 1, At, B1); PG8_BAR; PG8_SCHED;
            PG8_LDB(B0, 1, 0); PG8_LDB(B1, 1, 1); PG8_SCHED; PG8_LDA(At, 1, 0); PG8_STAGE(PG8_SA(0, 1), a2 + hstep, voffA);
            PG8_WAIT_V(8); PG8_WAIT_L(0); PG8_BAR; PG8_MMA(0, 0, At, B0); PG8_MMA(0, 1, At, B1); PG8_BAR; PG8_SCHED;
            PG8_LDA(At, 1, 1); PG8_STAGE(PG8_SB(1, 0), b3, voffB); PG8_STAGE(PG8_SB(1, 1), b3 + hstep, voffB); PG8_STAGE(PG8_SA(1, 0), a3, voffA);
            PG8_WAIT_V(8); PG8_WAIT_L(0); PG8_BAR; PG8_MMA(1, 0, At, B0); PG8_MMA(1, 1, At, B1); PG8_BAR; PG8_SCHED;
            } else {
            PG8_LDB(B0, 0, 0); PG8_SCHED; PG8_LDA(At, 0, 0); PG8_STAGE(PG8_SA(1, 1), a1 + hstep, voffA);
            PG8_WAIT_L(8); PG8_BAR; PG8_WAIT_L(0); PG8_MMA(0, 0, At, B0); PG8_BAR; PG8_SCHED;
            PG8_LDB(B1, 0, 1); PG8_STAGE(PG8_SB(0, 0), b2, voffB);
            PG8_BAR; PG8_WAIT_L(0); PG8_MMA(0, 1, At, B1); PG8_BAR;
            PG8_LDA(At, 0, 1); PG8_STAGE(PG8_SA(0, 0), a2, voffA);
            PG8_BAR; PG8_WAIT_L(0); PG8_MMA(1, 0, At, B0); PG8_BAR; PG8_SCHED;
            PG8_STAGE(PG8_SB(0, 1), b2 + hstep, voffB);
            PG8_WAIT_V(6); PG8_BAR; PG8_MMA(1, 1, At, B1); PG8_BAR;
            PG8_LDB(B0, 1, 0); PG8_SCHED; PG8_LDA(At, 1, 0); PG8_STAGE(PG8_SA(0, 1), a2 + hstep, voffA);
            PG8_WAIT_L(8); PG8_BAR; PG8_WAIT_L(0); PG8_MMA(0, 0, At, B0); PG8_BAR; PG8_SCHED;
            PG8_LDB(B1, 1, 1); PG8_STAGE(PG8_SB(1, 0), b3, voffB);
            PG8_BAR; PG8_WAIT_L(0); PG8_MMA(0, 1, At, B1); PG8_BAR;
            PG8_LDA(At, 1, 1); PG8_STAGE(PG8_SA(1, 0), a3, voffA);
            PG8_BAR; PG8_WAIT_L(0); PG8_MMA(1, 0, At, B0); PG8_BAR; PG8_SCHED;
            PG8_STAGE(PG8_SB(1, 1), b3 + hstep, voffB);
            PG8_WAIT_V(6); PG8_BAR; PG8_MMA(1, 1, At, B1); PG8_BAR;
            }
        }
        if constexpr (ALIGN_EPI) { if (wr == 0) PG8_BAR; }
        if constexpr (!Epi::AFTER_DRAIN) { E(acc, cur, wr, wc, fr, fq); S.done(cur); }
        if (!has_next) break;
#pragma unroll
        for (int a = 0; a < 2; ++a)
#pragma unroll
            for (int b = 0; b < 2; ++b)
#pragma unroll
                for (int m = 0; m < 4; ++m)
#pragma unroll
                    for (int n = 0; n < 2; ++n) acc[a][b][m][n] = (f32x4){0.f, 0.f, 0.f, 0.f};
        cur = nxt; cA = nA; cB = nB; ++ui;
        if constexpr (ALIGN_EPI) { if (wr == 1) PG8_BAR; }
    }
    PG8_WAIT_V(0);
    if constexpr (!ALIGN_EPI) { if (wr == 0) PG8_BAR; }
    PG8_BAR;
    if constexpr (Epi::AFTER_DRAIN) { E.fused(acc, cur, wr, wc, fr, fq, lds, wid, lane); S.done(cur); }
#undef PG8_SA
#undef PG8_SB
#undef PG8_STAGE
#undef PG8_LDA
#undef PG8_LDB
#undef PG8_MMA
#undef PG8_WAIT_V
#undef PG8_WAIT_L
#undef PG8_BAR
#undef PG8_SCHED
}
}
constexpr int NWAVES = 8;
constexpr int BATCH = 8, SEQ = 4096, D = 1024, M = BATCH * SEQ;
constexpr int DFF = 2816, NGU = 2 * DFF, DRW = 512, DCV = 512, NH = 8, HS = 64;
constexpr int DSHIFT = 3 * DRW + 64 + 64 + 128;
constexpr int DIN = DSHIFT + 2 * DCV;
constexpr int CONVW = 31;
constexpr float RMS_EPS = 1e-6f, GN_EPS = 64e-5f, LN_EPS = 1e-5f, DECAY_SCALE = 0.60653065971f;
#ifndef MK_ONE_LAUNCH
#define MK_ONE_LAUNCH 1
#endif
constexpr int N_PHASES = 11;

constexpr size_t MiB = 1u << 20;
constexpr size_t WS_CTL = 0, CTL_ZERO_BYTES = 1 * MiB;
constexpr size_t WS_WGU1 = 2 * MiB, WS_WDN1 = 13 * MiB, WS_WIN = 19 * MiB, WS_WOUT = 25 * MiB, WS_WGU2 = 27 * MiB, WS_WDN2 = 38 * MiB;
constexpr size_t WS_XN = 48 * MiB;
constexpr size_t WS_H = 112 * MiB;
constexpr size_t WS_F = 288 * MiB;
constexpr size_t WS_OAB = 416 * MiB;
constexpr size_t WS_END = 480 * MiB;
static_assert(WS_WGU1 + (size_t)NGU * D * 2 <= WS_WDN1 && WS_WDN1 + (size_t)D * DFF * 2 <= WS_WIN && WS_WIN + (size_t)DIN * D * 2 <= WS_WOUT && WS_WOUT + (size_t)D * D * 2 <= WS_WGU2 &&
              WS_WGU2 + (size_t)NGU * D * 2 <= WS_WDN2 && WS_WDN2 + (size_t)D * DFF * 2 <= WS_XN && WS_XN + (size_t)M * D * 2 <= WS_H && WS_H + (size_t)M * DFF * 2 <= WS_F &&
              WS_F + (size_t)M * D * 4 <= WS_OAB && WS_OAB + (size_t)M * D * 2 <= WS_END, "d_ws map");
constexpr int CW_TMO = 0, CW_CODE = 1;
constexpr int CW_BAR = 4096;

constexpr int RING_OFF = 0, RING_BYTES = 131072;
constexpr int LDSCTL_OFF = RING_BYTES, MISC_OFF = LDSCTL_OFF + 320;
constexpr int LDS_BYTES = 147456;
static_assert(MISC_OFF + 128 <= LDS_BYTES, "LDS map");
#define GAS __attribute__((address_space(1)))
#define LAS __attribute__((address_space(3)))
typedef unsigned short bf16;
typedef unsigned v4u __attribute__((ext_vector_type(4)));
typedef float f32x4 __attribute__((ext_vector_type(4)));
typedef short bf16x8 __attribute__((ext_vector_type(8)));
typedef GAS unsigned gu32;
typedef GAS unsigned long long gu64;
#define RLX_AGENT __ATOMIC_RELAXED, __HIP_MEMORY_SCOPE_AGENT
#define LDS_WAIT() asm volatile("s_waitcnt lgkmcnt(0)" ::: "memory")
#define VM_WAIT() asm volatile("s_waitcnt vmcnt(0)" ::: "memory")
__device__ __forceinline__ unsigned long long rt() { return __builtin_amdgcn_s_memrealtime(); }
__device__ __forceinline__ unsigned f2bf(float f) { unsigned u = __builtin_bit_cast(unsigned, f); return (u + 0x7fffu + ((u >> 16) & 1u)) >> 16; }
__device__ __forceinline__ unsigned pk2(float lo, float hi) { return f2bf(lo) | (f2bf(hi) << 16); }
#define XB_TMO      128
#define XB_XCNT(j)  (256  + 64 * (j))
#define XB_XSUB(j)  (1280 + 64 * (j))
#define XB_XGEN(j)  (2304 + 64 * (j))
#define XB_TOP      3328
#define XB_TOPGEN   3392
#define XCD_BAR_WORDS 3456
#define XB_SPIN_CAP (1u << 18)

__device__ __forceinline__ unsigned xb_ld(unsigned* p)              { return __hip_atomic_load(p, __ATOMIC_RELAXED, __HIP_MEMORY_SCOPE_AGENT); }
__device__ __forceinline__ unsigned xb_add(unsigned* p, unsigned v) { return __hip_atomic_fetch_add(p, v, __ATOMIC_RELAXED, __HIP_MEMORY_SCOPE_AGENT); }
__device__ __forceinline__ unsigned xb_xcc_id() { return (unsigned)__builtin_amdgcn_s_getreg((3 << 11) | 20) & 0xFu; }
#define XB_SPIN(cond, bar) do { unsigned _sp = 0; while (cond) { __builtin_amdgcn_s_sleep(1); \
    if ((++_sp & 255u) == 0u) { if (xb_ld(&(bar)[XB_TMO])) break; if (_sp > XB_SPIN_CAP) { atomicAdd(&(bar)[XB_TMO], 1u); break; } } } } while (0)

struct XcdBarrier {
    unsigned* bar; unsigned x;
    volatile LAS unsigned* st;
};

__device__ __forceinline__ XcdBarrier xcd_barrier_post(unsigned* bar, volatile LAS unsigned* st) {
    XcdBarrier b; b.bar = bar; b.x = xb_xcc_id(); b.st = st;
    if (threadIdx.x == 0) (void)xb_add(&bar[XB_XCNT(b.x)], 1u);
    return b;
}
__device__ __forceinline__ void xcd_barrier_complete(unsigned* bar, unsigned x, unsigned& nloc, unsigned& nx) {
    const unsigned G = gridDim.x * gridDim.y * gridDim.z;
    unsigned sum, cnt, mine, sp = 0u;
    for (;;) {
        sum = 0u; cnt = 0u; mine = 0u;
#pragma unroll
        for (unsigned j = 0; j < 16; ++j) { const unsigned c = xb_ld(&bar[XB_XCNT(j)]); sum += c; cnt += (c > 0u) ? 1u : 0u; mine = (j == x) ? c : mine; }
        if (sum == G) break;
        __builtin_amdgcn_s_sleep(1);
        if ((++sp & 255u) == 0u) { if (xb_ld(&bar[XB_TMO])) break; if (sp > XB_SPIN_CAP) { atomicAdd(&bar[XB_TMO], 1u); break; } }
    }
    nloc = mine > 0u ? mine : 1u; nx = cnt > 0u ? cnt : 1u;
}

__device__ __forceinline__ void xcd_barrier(const XcdBarrier& b) {
    asm volatile("s_waitcnt vmcnt(0)" ::: "memory");
    __syncthreads();
    if (threadIdx.x == 0) {
        unsigned* bar = b.bar;
        __builtin_amdgcn_s_waitcnt(0);
        unsigned nloc = b.st[0], nx = b.st[1];
        if (nloc == 0u) { xcd_barrier_complete(bar, b.x, nloc, nx); b.st[0] = nloc; b.st[1] = nx; }
        const unsigned old = xb_add(&bar[XB_XSUB(b.x)], 1u);
        const unsigned gen = old / nloc;
        if (old + 1u == (gen + 1u) * nloc) {
            __builtin_amdgcn_fence(__ATOMIC_RELEASE, "agent");
            asm volatile("s_waitcnt vmcnt(0)" ::: "memory");
            const unsigned og = xb_add(&bar[XB_TOP], 1u);
            const unsigned tg = og / nx;
            if (og + 1u == (tg + 1u) * nx) xb_add(&bar[XB_TOPGEN], 1u);
            else XB_SPIN(xb_ld(&bar[XB_TOPGEN]) == tg, bar);
            __builtin_amdgcn_fence(__ATOMIC_ACQUIRE, "agent");
            xb_add(&bar[XB_XGEN(b.x)], 1u);
            asm volatile("s_waitcnt vmcnt(0)" ::: "memory");
        } else {
            XB_SPIN(xb_ld(&bar[XB_XGEN(b.x)]) == gen, bar);
            __builtin_amdgcn_fence(__ATOMIC_ACQUIRE, "agent");
            asm volatile("s_waitcnt vmcnt(0)" ::: "memory");
        }
    }
    __syncthreads();
}
struct Frame {
    LAS unsigned char* lds;
    volatile LAS unsigned* MISC;
    gu32* ctl;
    int tid, lane, wave;
    int vcu, G;
    const float* in[28]; float* out;
    bf16 *Wgu1, *Wdn1, *Win, *Wout, *Wgu2, *Wdn2;
    bf16 *XN, *H, *OAB; float* Fm;
};
enum { I_X = 0, I_F1PRE, I_F1POST, I_F1GU, I_F1DN, I_MPRE, I_MPOST, I_WIN, I_MU, I_WUP, I_W0, I_AUP, I_A0, I_GUP, I_KK, I_KA, I_RK, I_GNW, I_GNB, I_CDW, I_CB, I_CLW, I_CLB, I_WOUT, I_F2PRE, I_F2POST, I_F2GU, I_F2DN };

__device__ __forceinline__ float wave_sum(float v) {
#pragma unroll
    for (int o = 1; o < 64; o <<= 1) v += __shfl_xor(v, o);
    return v;
}
__device__ __forceinline__ float bf2f(bf16 v) { return __uint_as_float(((unsigned)v) << 16); }
__device__ __forceinline__ float sigm(float x) { return 1.0f / (1.0f + __expf(-x)); }

__device__ __forceinline__ void p0_transpose_item(const float* W, int K, int N, bf16* WT, int gu, LAS float* scr, int item, int lane) {
    const int nblk = N / 32, kb = item / nblk, nb = item % nblk, k0 = 64 * kb, n0 = 32 * nb;
    int r0 = n0;
    if (gu) { const int up = n0 >= DFF ? 1 : 0, nn = n0 - up * DFF; r0 = (nn >> 7) * 256 + up * 128 + (nn & 127); }
#pragma unroll 8
    for (int i = 0; i < 32; ++i) { const int kk = 2 * i + (lane >> 5); scr[kk * 33 + (lane & 31)] = W[(size_t)(k0 + kk) * N + n0 + (lane & 31)]; }
    LDS_WAIT(); asm volatile("" ::: "memory");
    const int c = lane & 7;
#pragma unroll
    for (int j = 0; j < 4; ++j) { const int n = (lane >> 3) + 8 * j; const LAS float* s = scr + (8 * c) * 33 + n;
        v4u o; o.x = pk2(s[0 * 33], s[1 * 33]); o.y = pk2(s[2 * 33], s[3 * 33]); o.z = pk2(s[4 * 33], s[5 * 33]); o.w = pk2(s[6 * 33], s[7 * 33]);
        *(GAS v4u*)(WT + (size_t)(r0 + n) * K + k0 + 8 * c) = o; }
    LDS_WAIT(); asm volatile("" ::: "memory");
}
__device__ __forceinline__ void rms_row_to_bf16(Frame& F, const float* xrow, const float* g, bf16* orow) {
    const GAS f32x4* xr = (const GAS f32x4*)xrow + F.lane; const GAS f32x4* gr = (const GAS f32x4*)g + F.lane;
    f32x4 v[4]; float s = 0.f;
#pragma unroll
    for (int j = 0; j < 4; ++j) { v[j] = xr[64 * j]; s += (v[j].x * v[j].x + v[j].y * v[j].y) + (v[j].z * v[j].z + v[j].w * v[j].w); }
    const float r = 1.0f / sqrtf(wave_sum(s) * (1.f / D) + RMS_EPS);
    GAS unsigned long long* o8 = (GAS unsigned long long*)orow + F.lane;
#pragma unroll
    for (int j = 0; j < 4; ++j) { const f32x4 gg = gr[64 * j]; o8[64 * j] = (unsigned long long)pk2(v[j].x * r * gg.x, v[j].y * r * gg.y) | ((unsigned long long)pk2(v[j].z * r * gg.z, v[j].w * r * gg.w) << 32); }
}
__device__ __forceinline__ void p0_prologue(Frame& F) {
    LAS float* scr = (LAS float*)(F.lds + RING_OFF + F.wave * 16384);
    const int gw = F.vcu * NWAVES + F.wave, NGW = F.G * NWAVES;
    constexpr int I_GU = (D / 64) * (NGU / 32), I_DN = (DFF / 64) * (D / 32), I_IN = (D / 64) * (DIN / 32), I_OUT = (D / 64) * (D / 32);
    constexpr int NITEMS = 2 * I_GU + 2 * I_DN + I_IN + I_OUT;
    for (int it = gw; it < NITEMS; it += NGW) {
        int r = it;
        if (r < I_GU) { p0_transpose_item(F.in[I_F1GU], D, NGU, F.Wgu1, 1, scr, r, F.lane); continue; } r -= I_GU;
        if (r < I_GU) { p0_transpose_item(F.in[I_F2GU], D, NGU, F.Wgu2, 1, scr, r, F.lane); continue; } r -= I_GU;
        if (r < I_DN) { p0_transpose_item(F.in[I_F1DN], DFF, D, F.Wdn1, 0, scr, r, F.lane); continue; } r -= I_DN;
        if (r < I_DN) { p0_transpose_item(F.in[I_F2DN], DFF, D, F.Wdn2, 0, scr, r, F.lane); continue; } r -= I_DN;
        if (r < I_IN) { p0_transpose_item(F.in[I_WIN], D, DIN, F.Win, 0, scr, r, F.lane); continue; } r -= I_IN;
        p0_transpose_item(F.in[I_WOUT], D, D, F.Wout, 0, scr, r, F.lane);
    }
    for (int m = gw; m < M; m += NGW) rms_row_to_bf16(F, F.in[I_X] + (size_t)m * D, F.in[I_F1PRE], F.XN + (size_t)m * D);
}
__device__ __forceinline__ void norm_pass(Frame& F, const float* Fm, const float* base, float* out, const float* gpost, float scale, const float* gpre, bf16* xn) {
    const int gw = F.vcu * NWAVES + F.wave, NGW = F.G * NWAVES;
    for (int m = gw; m < M; m += NGW) {
        const GAS f32x4* fr = (const GAS f32x4*)(Fm + (size_t)m * D) + F.lane; const GAS f32x4* br = (const GAS f32x4*)(base + (size_t)m * D) + F.lane;
        const GAS f32x4* gp = (const GAS f32x4*)gpost + F.lane;
        f32x4 f[4], o[4]; float s = 0.f;
#pragma unroll
        for (int j = 0; j < 4; ++j) { f[j] = fr[64 * j]; o[j] = br[64 * j]; s += (f[j].x * f[j].x + f[j].y * f[j].y) + (f[j].z * f[j].z + f[j].w * f[j].w); }
        const float r = scale / sqrtf(wave_sum(s) * (1.f / D) + RMS_EPS);
        float s2 = 0.f;
#pragma unroll
        for (int j = 0; j < 4; ++j) { const f32x4 g = gp[64 * j]; o[j] = o[j] + f[j] * r * g; s2 += (o[j].x * o[j].x + o[j].y * o[j].y) + (o[j].z * o[j].z + o[j].w * o[j].w); }
        GAS f32x4* orow = (GAS f32x4*)(out + (size_t)m * D) + F.lane;
#pragma unroll
        for (int j = 0; j < 4; ++j) orow[64 * j] = o[j];
        if (xn) {
            const float r2 = 1.0f / sqrtf(wave_sum(s2) * (1.f / D) + RMS_EPS);
            const GAS f32x4* gq = (const GAS f32x4*)gpre + F.lane;
            GAS unsigned long long* o8 = (GAS unsigned long long*)(xn + (size_t)m * D) + F.lane;
#pragma unroll
            for (int j = 0; j < 4; ++j) { const f32x4 gg = gq[64 * j]; o8[64 * j] = (unsigned long long)pk2(o[j].x * r2 * gg.x, o[j].y * r2 * gg.y) | ((unsigned long long)pk2(o[j].z * r2 * gg.z, o[j].w * r2 * gg.w) << 32); }
        }
    }
}

__device__ __forceinline__ void conv_unit(Frame& F, const bf16* P, int unit) {
    const int b = unit / (SEQ / 32), t0 = (unit % (SEQ / 32)) * 32, c = F.tid;
    LAS float* sG = (LAS float*)(F.lds + RING_OFF);
    LAS float* sRed = sG + 62 * 512;
    for (int rr = 0; rr < 62; ++rr) { const int t = t0 - 30 + rr; float v = 0.f;
        if (t >= 0) { const bf16* pr = P + (size_t)(b * SEQ + t) * DIN + DSHIFT; const float a = bf2f(pr[c]), g = bf2f(pr[DCV + c]); v = a * sigm(g); }
        sG[rr * 512 + c] = v; }
    float w[CONVW];
#pragma unroll
    for (int j = 0; j < CONVW; ++j) w[j] = F.in[I_CDW][j * DCV + c];
    const float cb = F.in[I_CB][c], lw = F.in[I_CLW][c], lb = F.in[I_CLB][c];
#pragma unroll 1
    for (int tt = 0; tt < 32; ++tt) { float a = cb;
#pragma unroll
        for (int j = 0; j < CONVW; ++j) a += w[j] * sG[(tt + j) * 512 + c];
        sG[tt * 512 + c] = a;
        const float s = wave_sum(a); if (F.lane == 0) sRed[tt * 8 + F.wave] = s; }
    __syncthreads();
#pragma unroll 1
    for (int tt = 0; tt < 32; ++tt) { float s = 0.f;
#pragma unroll
        for (int k = 0; k < 8; ++k) s += sRed[tt * 8 + k];
        sG[tt * 512 + c] -= s * (1.f / DCV); }
    __syncthreads();
#pragma unroll 1
    for (int tt = 0; tt < 32; ++tt) { const float d = sG[tt * 512 + c]; const float s = wave_sum(d * d); if (F.lane == 0) sRed[tt * 8 + F.wave] = s; }
    __syncthreads();
#pragma unroll 1
    for (int tt = 0; tt < 32; ++tt) { float s = 0.f;
#pragma unroll
        for (int k = 0; k < 8; ++k) s += sRed[tt * 8 + k];
        const float v = sG[tt * 512 + c] * (1.0f / sqrtf(s * (1.f / DCV) + LN_EPS)) * lw + lb;
        F.OAB[(size_t)(b * SEQ + t0 + tt) * D + DRW + c] = (bf16)f2bf(v * sigm(v)); }
    __syncthreads();
}

__device__ __forceinline__ float dpp_add(float v, const int ctrl_sel) {
    int r;
    if (ctrl_sel == 0) r = __builtin_amdgcn_update_dpp(0, __builtin_bit_cast(int, v), 0xB1, 0xF, 0xF, true);
    else if (ctrl_sel == 1) r = __builtin_amdgcn_update_dpp(0, __builtin_bit_cast(int, v), 0x4E, 0xF, 0xF, true);
    else r = __builtin_amdgcn_update_dpp(0, __builtin_bit_cast(int, v), 0x141, 0xF, 0xF, true);
    return v + __builtin_bit_cast(float, r);
}
__device__ __forceinline__ float red8(float v) { v = dpp_add(v, 0); v = dpp_add(v, 1); v = dpp_add(v, 2); return v; }

__device__ __forceinline__ void rwkv_seq(Frame& F, const bf16* P, int bh) {
    const int b = bh >> 3, h = bh & 7, tid = F.tid, lane = F.lane, wv = F.wave;
    LAS float* sR = (LAS float*)(F.lds + RING_OFF); LAS float* sK = sR + 2048; LAS float* sV = sK + 2048; LAS float* sW = sV + 2048; LAS float* sA = sW + 2048;
    LAS float* sG = sA + 2048; LAS float* sKK = sG + 2048; LAS float* sY = sKK + 2048; LAS float* sXG = sY + 2048; LAS float* sBon = sXG + 4096;
    const int hj = h * 64 + lane;
    const float w0j = F.in[I_W0][hj], a0j = F.in[I_A0][hj], kkj = F.in[I_KK][hj], kaj = F.in[I_KA][hj], rkj = F.in[I_RK][hj], gnwj = F.in[I_GNW][hj], gnbj = F.in[I_GNB][hj];
    const int colg[7] = {h * 64, DRW + h * 64, 2 * DRW + h * 64, 3 * DRW, 3 * DRW + 64, 3 * DRW + 128, 3 * DRW + 192};
    float mu[7];
#pragma unroll
    for (int g = 0; g < 7; ++g) mu[g] = F.in[I_MU][colg[g] + lane];
    const float* wup = F.in[I_WUP] + hj; const float* aup = F.in[I_AUP] + hj; const float* gup = F.in[I_GUP] + hj;
    float st[8];
#pragma unroll
    for (int j = 0; j < 8; ++j) st[j] = 0.f;
    const int ri = tid >> 3, c0 = (tid & 7) * 8, tb = wv * 4;
    for (int stage = 0; stage < SEQ / 32; ++stage) {
        const int t0 = stage * 32;
#pragma unroll
        for (int g = 0; g < 7; ++g) {
            for (int tt = wv; tt < 32; tt += 8) {
                const size_t row = (size_t)b * SEQ + t0 + tt;
                const float cur = bf2f(P[row * DIN + colg[g] + lane]);
                const float prev = (t0 + tt > 0) ? bf2f(P[(row - 1) * DIN + colg[g] + lane]) : 0.f;
                float v = cur + (prev - cur) * mu[g];
                if (g == 0) sR[tt * 64 + lane] = v;
                else if (g == 1) sK[tt * 64 + lane] = v;
                else if (g == 2) sV[tt * 64 + lane] = v;
                else if (g == 3) sW[tt * 64 + lane] = tanhf(v);
                else if (g == 4) sA[tt * 64 + lane] = v;
                else sXG[tt * 128 + (g - 5) * 64 + lane] = sigm(v);
            }
        }
        __syncthreads();
        float aD[4], aA[4], aG[4];
#pragma unroll
        for (int i = 0; i < 4; ++i) { aD[i] = w0j; aA[i] = a0j; aG[i] = 0.f; }
        for (int k = 0; k < 64; ++k) { const float wu = wup[k * DRW], au = aup[k * DRW];
#pragma unroll
            for (int i = 0; i < 4; ++i) { aD[i] += sW[(tb + i) * 64 + k] * wu; aA[i] += sA[(tb + i) * 64 + k] * au; } }
        for (int k = 0; k < 128; ++k) { const float gu = gup[k * DRW];
#pragma unroll
            for (int i = 0; i < 4; ++i) aG[i] += sXG[(tb + i) * 128 + k] * gu; }
        __syncthreads();
#pragma unroll
        for (int i = 0; i < 4; ++i) { const int t = tb + i;
            const float dec = __expf(-DECAY_SCALE * sigm(aD[i])), a = sigm(aA[i]);
            const float kraw = sK[t * 64 + lane], kkr = kraw * kkj; const float ss = wave_sum(kkr * kkr);
            const float kk = kkr * (1.0f / sqrtf(fmaxf(ss, 1e-12f)));
            const float kp = kraw * (1.0f + (a - 1.0f) * kaj);
            const float bon = wave_sum(sR[t * 64 + lane] * kp * rkj);
            sW[t * 64 + lane] = dec; sA[t * 64 + lane] = a; sG[t * 64 + lane] = aG[i]; sKK[t * 64 + lane] = kk; sK[t * 64 + lane] = kp; if (lane == 0) sBon[t] = bon; }
        __syncthreads();
        for (int t = 0; t < 32; ++t) {
            const f32x4 k0 = *(const LAS f32x4*)(sKK + t * 64 + c0), k1 = *(const LAS f32x4*)(sKK + t * 64 + c0 + 4);
            const f32x4 a0 = *(const LAS f32x4*)(sA + t * 64 + c0), a1 = *(const LAS f32x4*)(sA + t * 64 + c0 + 4);
            const f32x4 w0 = *(const LAS f32x4*)(sW + t * 64 + c0), w1 = *(const LAS f32x4*)(sW + t * 64 + c0 + 4);
            const f32x4 q0 = *(const LAS f32x4*)(sK + t * 64 + c0), q1 = *(const LAS f32x4*)(sK + t * 64 + c0 + 4);
            const f32x4 r0 = *(const LAS f32x4*)(sR + t * 64 + c0), r1 = *(const LAS f32x4*)(sR + t * 64 + c0 + 4);
            const float v = sV[t * 64 + ri];
            const float kkv[8] = {k0[0], k0[1], k0[2], k0[3], k1[0], k1[1], k1[2], k1[3]};
            const float av[8] = {a0[0], a0[1], a0[2], a0[3], a1[0], a1[1], a1[2], a1[3]};
            const float wv8[8] = {w0[0], w0[1], w0[2], w0[3], w1[0], w1[1], w1[2], w1[3]};
            const float kv[8] = {q0[0], q0[1], q0[2], q0[3], q1[0], q1[1], q1[2], q1[3]};
            const float rv[8] = {r0[0], r0[1], r0[2], r0[3], r1[0], r1[1], r1[2], r1[3]};
            float sz = 0.f;
#pragma unroll
            for (int j = 0; j < 8; ++j) sz -= st[j] * kkv[j];
            sz = red8(sz);
            float y = 0.f;
#pragma unroll
            for (int j = 0; j < 8; ++j) { st[j] = st[j] * wv8[j] + sz * (kkv[j] * av[j]) + v * kv[j]; y += st[j] * rv[j]; }
            y = red8(y);
            if ((tid & 7) == 0) sY[t * 64 + ri] = y;
        }
        __syncthreads();
#pragma unroll
        for (int i = 0; i < 4; ++i) { const int t = tb + i;
            const float y = sY[t * 64 + lane]; const float mean = wave_sum(y) * (1.f / 64.f); const float d = y - mean; const float var = wave_sum(d * d) * (1.f / 64.f);
            float yn = d * (1.0f / sqrtf(var + GN_EPS)) * gnwj + gnbj;
            yn += sBon[t] * sV[t * 64 + lane];
            F.OAB[((size_t)b * SEQ + t0 + t) * D + hj] = (bf16)f2bf(yn * sG[t * 64 + lane]); }
        __syncthreads();
    }
}

struct Args { const float* in[28]; float* out; unsigned char* ws; int ph_lo, ph_hi; };
__global__ void __launch_bounds__(NWAVES * 64, 2) mk_fwd(Args args) {
    extern __shared__ __attribute__((aligned(16))) unsigned char lds[];
    Frame F;
    F.lds = (LAS unsigned char*)lds;
    F.MISC = (volatile LAS unsigned*)(F.lds + MISC_OFF);
    F.tid = threadIdx.x; F.lane = F.tid & 63; F.wave = __builtin_amdgcn_readfirstlane(F.tid >> 6);
    F.G = gridDim.x; { const int bx = blockIdx.x; F.vcu = (F.G % 8 == 0) ? (bx % 8) * (F.G / 8) + bx / 8 : bx; }
    unsigned char* ws = args.ws;
    F.ctl = (gu32*)(ws + WS_CTL);
#pragma unroll
    for (int i = 0; i < 28; ++i) F.in[i] = args.in[i];
    F.out = args.out;
    F.Wgu1 = (bf16*)(ws + WS_WGU1); F.Wdn1 = (bf16*)(ws + WS_WDN1); F.Win = (bf16*)(ws + WS_WIN); F.Wout = (bf16*)(ws + WS_WOUT); F.Wgu2 = (bf16*)(ws + WS_WGU2); F.Wdn2 = (bf16*)(ws + WS_WDN2);
    F.XN = (bf16*)(ws + WS_XN); F.H = (bf16*)(ws + WS_H); F.OAB = (bf16*)(ws + WS_OAB); F.Fm = (float*)(ws + WS_F);
    for (int u = F.tid; u < (LDS_BYTES - LDSCTL_OFF) / 4; u += NWAVES * 64) ((LAS unsigned*)(F.lds + LDSCTL_OFF))[u] = 0u;
    __syncthreads();
    XcdBarrier bar; bar.bar = (unsigned*)(F.ctl + CW_BAR); bar.x = 0; bar.st = nullptr;
    if (MK_ONE_LAUNCH) bar = xcd_barrier_post((unsigned*)(F.ctl + CW_BAR), F.MISC + 8);
    const int lo = args.ph_lo, hi = args.ph_hi;
#ifndef PH_MASK
#define PH_MASK 0xFFFF
#endif
#define IN(k) (((PH_MASK >> (k)) & 1) && lo <= (k) && (k) < hi)
#define SEAM(k) do { if (IN(k) && IN((k) + 1)) xcd_barrier(bar); } while (0)

    if (IN(0)) { p0_prologue(F); } SEAM(0);
    if (IN(1)) { pg8::Gemm g{F.XN, F.Wgu1, M, NGU, D}; pg8::StaticOrder S; S.init(M, NGU, F.G, (int)blockIdx.x); pg8::EpiSwiGLU E{F.H, DFF};
        pg8::gemm_phase<pg8::EpiSwiGLU, pg8::StaticOrder, true, true>(F.lds + RING_OFF, g, S, E); } SEAM(1);
    if (IN(2)) { pg8::Gemm g{F.H, F.Wdn1, M, D, DFF}; pg8::StaticOrder S; S.init(M, D, F.G, (int)blockIdx.x); pg8::EpiF32 E{F.Fm, D};
        pg8::gemm_phase<pg8::EpiF32, pg8::StaticOrder, true, true>(F.lds + RING_OFF, g, S, E); } SEAM(2);
    if (IN(3)) { norm_pass(F, F.Fm, F.in[I_X], F.out, F.in[I_F1POST], 0.5f, F.in[I_MPRE], F.XN); } SEAM(3);
    if (IN(4)) { pg8::Gemm g{F.XN, F.Win, M, DIN, D}; pg8::StaticOrder S; S.init(M, DIN, F.G, (int)blockIdx.x); pg8::EpiBf16 E{F.H, DIN};
        pg8::gemm_phase<pg8::EpiBf16, pg8::StaticOrder, true, true>(F.lds + RING_OFF, g, S, E); } SEAM(4);
    if (IN(5)) {
        if ((int)blockIdx.x < BATCH * NH) rwkv_seq(F, F.H, (int)blockIdx.x);
        else for (int u = (int)blockIdx.x - BATCH * NH; u < M / 32; u += F.G - BATCH * NH) conv_unit(F, F.H, u);
    } SEAM(5);
    if (IN(6)) { pg8::Gemm g{F.OAB, F.Wout, M, D, D}; pg8::StaticOrder S; S.init(M, D, F.G, (int)blockIdx.x); pg8::EpiF32 E{F.Fm, D};
        pg8::gemm_phase<pg8::EpiF32, pg8::StaticOrder, true, true>(F.lds + RING_OFF, g, S, E); } SEAM(6);
    if (IN(7)) { norm_pass(F, F.Fm, F.out, F.out, F.in[I_MPOST], 1.0f, F.in[I_F2PRE], F.XN); } SEAM(7);
    if (IN(8)) { pg8::Gemm g{F.XN, F.Wgu2, M, NGU, D}; pg8::StaticOrder S; S.init(M, NGU, F.G, (int)blockIdx.x); pg8::EpiSwiGLU E{F.H, DFF};
        pg8::gemm_phase<pg8::EpiSwiGLU, pg8::StaticOrder, true, true>(F.lds + RING_OFF, g, S, E); } SEAM(8);
    if (IN(9)) { pg8::Gemm g{F.H, F.Wdn2, M, D, DFF}; pg8::StaticOrder S; S.init(M, D, F.G, (int)blockIdx.x); pg8::EpiF32 E{F.Fm, D};
        pg8::gemm_phase<pg8::EpiF32, pg8::StaticOrder, true, true>(F.lds + RING_OFF, g, S, E); } SEAM(9);
    if (IN(10)) { norm_pass(F, F.Fm, F.out, F.out, F.in[I_F2POST], 0.5f, nullptr, nullptr); }
#undef IN
#undef SEAM
}

extern "C" void kernel_launch(void* const* d_in, const int* in_sizes, int n_in, void* d_out, int out_size, void* d_ws, size_t ws_size, hipStream_t stream) {
    static int grid = 0;
    if (grid == 0) {
        if (n_in != 28 || in_sizes[0] != M * D || out_size != M * D || ws_size < WS_END) { fprintf(stderr, "kernel_launch: unexpected shapes (n_in %d, in0 %d, out %d, ws %zu); nothing launched\n", n_in, n_in > 0 ? in_sizes[0] : -1, out_size, ws_size); grid = -1; return; }
        int dev = 0, cus = 0, per_cu = 0;
        if (hipGetDevice(&dev) != hipSuccess || hipDeviceGetAttribute(&cus, hipDeviceAttributeMultiprocessorCount, dev) != hipSuccess) { grid = -1; return; }
        if (hipFuncSetAttribute((const void*)mk_fwd, hipFuncAttributeMaxDynamicSharedMemorySize, LDS_BYTES) != hipSuccess) { fprintf(stderr, "kernel_launch: hipFuncSetAttribute failed\n"); grid = -1; return; }
        if (hipOccupancyMaxActiveBlocksPerMultiprocessor(&per_cu, (const void*)mk_fwd, NWAVES * 64, LDS_BYTES) != hipSuccess || per_cu < 1) { fprintf(stderr, "kernel_launch: occupancy query says %d blocks per CU; nothing launched\n", per_cu); (void)hipGetLastError(); grid = -1; return; }
        grid = cus;
    }
    if (grid < 0) return;
    if (hipMemsetAsync((char*)d_ws + WS_CTL, 0, CTL_ZERO_BYTES, stream) != hipSuccess) { fprintf(stderr, "kernel_launch: hipMemsetAsync failed\n"); return; }
    Args a{};
    for (int i = 0; i < 28; ++i) a.in[i] = (const float*)d_in[i];
    a.out = (float*)d_out; a.ws = (unsigned char*)d_ws;
#if MK_ONE_LAUNCH
    a.ph_lo = 0; a.ph_hi = N_PHASES;
    hipLaunchKernelGGL(mk_fwd, dim3(grid), dim3(NWAVES * 64), LDS_BYTES, stream, a);
#else
    for (int p = 0; p < N_PHASES; ++p) { a.ph_lo = p; a.ph_hi = p + 1; hipLaunchKernelGGL(mk_fwd, dim3(grid), dim3(NWAVES * 64), LDS_BYTES, stream, a); }
#endif
    const hipError_t le = hipPeekAtLastError();
    if (le != hipSuccess) fprintf(stderr, "kernel_launch: launch failed: %s\n", hipGetErrorName(le));
}
```

```cpp
#include <hip/hip_runtime.h>
#include <cstdio>
#include <cstdint>
namespace pg8 {
#define PG8_LAS __attribute__((address_space(3)))
typedef unsigned short bf16_t;
typedef short bf16x8 __attribute__((ext_vector_type(8)));
typedef float f32x4 __attribute__((ext_vector_type(4)));
typedef unsigned u32x4 __attribute__((ext_vector_type(4)));
constexpr int BM = 256, BK = 64, HALF = 128, HTB = HALF * BK * 2  , STAGE_BYTES = 8 * HTB, NXCD = 8, WGM = 8;

__host__ __device__ __forceinline__ int lds_byte(int r, int c) { const int st = (r >> 4) * 2 + (c >> 5), rr = r & 15, cc = c & 31, ob = rr * 64 + cc * 2; return st * 1024 + (ob ^ (((ob >> 9) & 1) << 5)); }
__host__ __device__ __forceinline__ void stage_rc(int b, int& R, int& C) { const int st = b / 1024, sb = b % 1024, swz = sb ^ (((sb >> 9) & 1) << 5); R = (st >> 1) * 16 + swz / 64; C = (st & 1) * 32 + (swz % 64) / 2; }
__host__ __device__ __forceinline__ int perm32(int rho) { const int n = rho >> 4, i = rho & 15; return 8 * (i >> 2) + 4 * n + (i & 3); }

struct Unit { int pm, pn; };
struct Gemm { const bf16_t* A; const bf16_t* Bt; int M, N, K; };

struct StaticOrder {
    int nM, nN, nwg, G, c;
    __host__ __device__ void init(int M, int N, int G_, int c_) { nM = M / BM; nN = N / BM; nwg = nM * nN; G = G_; c = c_; }
    __host__ __device__ bool next(int i, Unit& u) const {
        const long L = (long)i * G + c; if (L >= nwg) return false;
        int wgid = (int)L; { const int q = nwg / NXCD, r = nwg % NXCD, xcd = wgid % NXCD, off = wgid / NXCD; wgid = (xcd < r ? xcd * (q + 1) : r * (q + 1) + (xcd - r) * q) + off; }
        const int nig = WGM * nN, gid = wgid / nig, fm = gid * WGM, gsz = (nM - fm) < WGM ? (nM - fm) : WGM;
        u.pm = fm + ((wgid % nig) % gsz); u.pn = (wgid % nig) / gsz; return true;
    }
    __device__ __forceinline__ void a_ready(const Unit&) const {}
    __device__ __forceinline__ void done(const Unit&) const {}
};
__device__ __forceinline__ unsigned cvt_pk_bf16(float lo, float hi) { unsigned r; asm volatile("v_cvt_pk_bf16_f32 %0, %1, %2" : "=v"(r) : "v"(lo), "v"(hi)); return r; }
typedef float f32x2 __attribute__((ext_vector_type(2)));
__device__ __forceinline__ float silu_mul(float g, float u) { const float e = __builtin_amdgcn_exp2f(g * -1.44269504f); return g * __builtin_amdgcn_rcpf(1.0f + e) * u; }

struct EpiBf16 {
    static constexpr bool PERM = true, AFTER_DRAIN = false;
    bf16_t* O; int ldc;
    __device__ __forceinline__ void operator()(const f32x4 (&acc)[2][2][4][2], const Unit& u, int wr, int wc, int fr, int fq) const {
        const int row0 = u.pm * BM + wr * 64 + fr; const int col0 = u.pn * BM + wc * 32 + 8 * fq;
#pragma unroll
        for (int ai = 0; ai < 2; ++ai)
#pragma unroll
            for (int m = 0; m < 4; ++m) { bf16_t* rowp = O + (size_t)(row0 + ai * HALF + m * 16) * ldc + col0;
#pragma unroll
                for (int bj = 0; bj < 2; ++bj) { const f32x4 v0 = acc[ai][bj][m][0], v1 = acc[ai][bj][m][1];
                    u32x4 w; w.x = cvt_pk_bf16(v0[0], v0[1]); w.y = cvt_pk_bf16(v0[2], v0[3]); w.z = cvt_pk_bf16(v1[0], v1[1]); w.w = cvt_pk_bf16(v1[2], v1[3]);
                    *(u32x4*)(rowp + bj * HALF) = w; } }
    }
};
struct EpiSwiGLU {
    static constexpr bool PERM = true, AFTER_DRAIN = false;
    bf16_t* H; int ldh;
    __device__ __forceinline__ void operator()(const f32x4 (&acc)[2][2][4][2], const Unit& u, int wr, int wc, int fr, int fq) const {
        const int row0 = u.pm * BM + wr * 64 + fr; const int col0 = u.pn * HALF + wc * 32 + 8 * fq;
#pragma unroll
        for (int ai = 0; ai < 2; ++ai)
#pragma unroll
            for (int m = 0; m < 4; ++m) { bf16_t* rowp = H + (size_t)(row0 + ai * HALF + m * 16) * ldh + col0;
                const f32x4 g0 = acc[ai][0][m][0], g1 = acc[ai][0][m][1], u0 = acc[ai][1][m][0], u1 = acc[ai][1][m][1];
                u32x4 w; w.x = cvt_pk_bf16(silu_mul(g0[0], u0[0]), silu_mul(g0[1], u0[1])); w.y = cvt_pk_bf16(silu_mul(g0[2], u0[2]), silu_mul(g0[3], u0[3]));
                w.z = cvt_pk_bf16(silu_mul(g1[0], u1[0]), silu_mul(g1[1], u1[1])); w.w = cvt_pk_bf16(silu_mul(g1[2], u1[2]), silu_mul(g1[3], u1[3]));
                *(u32x4*)rowp = w; }
    }
};
struct EpiF32 {
    static constexpr bool PERM = false, AFTER_DRAIN = false;
    float* C; int ldc;
    __device__ __forceinline__ void operator()(const f32x4 (&acc)[2][2][4][2], const Unit& u, int wr, int wc, int fr, int fq) const {
        const int row0 = u.pm * BM + wr * 64 + fr, col0 = u.pn * BM + wc * 32 + 4 * fq;
#pragma unroll
        for (int ai = 0; ai < 2; ++ai)
#pragma unroll
            for (int m = 0; m < 4; ++m) { float* rowp = C + (size_t)(row0 + ai * HALF + m * 16) * ldc + col0;
#pragma unroll
                for (int bj = 0; bj < 2; ++bj)
#pragma unroll
                    for (int n = 0; n < 2; ++n) *(f32x4*)(rowp + bj * HALF + n * 16) = acc[ai][bj][m][n]; }
    }
};
template <class Epi, class Sched, bool ALIGN_EPI = false, bool SP2 = false>
__device__ __forceinline__ void gemm_phase(PG8_LAS unsigned char* lds, const Gemm g, const Sched& S, const Epi& E) {
    const int tid = threadIdx.x, wid = __builtin_amdgcn_readfirstlane(tid >> 6), lane = tid & 63, wr = wid >> 2, wc = wid & 3, fr = lane & 15, fq = lane >> 4;
    const int K = g.K, nt = K / BK;
    unsigned voffA[2], voffB[2];
#pragma unroll
    for (int i = 0; i < 2; ++i) { int R, C; stage_rc(tid * 16 + i * 8192, R, C); const int Rb = Epi::PERM ? ((R & ~31) + perm32(R & 31)) : R;
        voffA[i] = (unsigned)(R * K + C) * 2u; voffB[i] = (unsigned)(Rb * K + C) * 2u; }
    const size_t kstep = (size_t)(BK * 2);
    const size_t hstep = (size_t)HALF * K * 2;
    const size_t tstep = 2 * hstep;
    const unsigned ldsw = (unsigned)wid * 1024u;
    const int aoff = lds_byte(wr * 64 + fr, fq * 8), boff = lds_byte(wc * 32 + fr, fq * 8);
#define PG8_SA(b, h) (((b) * 2 + (h)) * HTB)
#define PG8_SB(b, h) ((4 + (b) * 2 + (h)) * HTB)
#define PG8_STAGE(bufoff, gbase, voff) do { _Pragma("unroll") for (int _i = 0; _i < 2; ++_i) \
        __builtin_amdgcn_global_load_lds((const unsigned*)((const char*)(gbase) + (voff)[_i]), (PG8_LAS unsigned*)(lds + (bufoff) + ldsw + _i * 8192), 16, 0, 0); } while (0)
#define PG8_LDA(dst, b, h) do { _Pragma("unroll") for (int m = 0; m < 4; ++m) _Pragma("unroll") for (int k = 0; k < 2; ++k) dst[m][k] = *(const PG8_LAS bf16x8*)(lds + PG8_SA(b, h) + aoff + m * 2048 + k * 1024); } while (0)
#define PG8_LDB(dst, b, h) do { _Pragma("unroll") for (int n = 0; n < 2; ++n) _Pragma("unroll") for (int k = 0; k < 2; ++k) dst[n][k] = *(const PG8_LAS bf16x8*)(lds + PG8_SB(b, h) + boff + n * 2048 + k * 1024); } while (0)
#define PG8_MMA(ai, bj, At, Bt) do { __builtin_amdgcn_s_setprio(1); _Pragma("unroll") for (int m = 0; m < 4; ++m) _Pragma("unroll") for (int n = 0; n < 2; ++n) _Pragma("unroll") for (int k = 0; k < 2; ++k) \
        acc[ai][bj][m][n] = __builtin_amdgcn_mfma_f32_16x16x32_bf16(Bt[n][k], At[m][k], acc[ai][bj][m][n], 0, 0, 0); __builtin_amdgcn_s_setprio(0); } while (0)
#define PG8_WAIT_V(n) asm volatile("s_waitcnt vmcnt(" #n ")" ::: "memory")
#define PG8_WAIT_L(n) asm volatile("s_waitcnt lgkmcnt(" #n ")" ::: "memory")
#define PG8_BAR __builtin_amdgcn_s_barrier()
#define PG8_SCHED __builtin_amdgcn_sched_barrier(0)
    Unit cur, nxt; int ui = 0;
    if (!S.next(0, cur)) return;
    f32x4 acc[2][2][4][2];
#pragma unroll
    for (int a = 0; a < 2; ++a)
#pragma unroll
        for (int b = 0; b < 2; ++b)
#pragma unroll
            for (int m = 0; m < 4; ++m)
#pragma unroll
                for (int n = 0; n < 2; ++n) acc[a][b][m][n] = (f32x4){0.f, 0.f, 0.f, 0.f};
    bf16x8 At[4][2], B0[2][2], B1[2][2];
    const char* cA = (const char*)g.A + (size_t)cur.pm * tstep; const char* cB = (const char*)g.Bt + (size_t)cur.pn * tstep;
    S.a_ready(cur);
    if constexpr (SP2) {
        PG8_STAGE(PG8_SB(0, 0), cB, voffB); PG8_STAGE(PG8_SB(0, 1), cB + hstep, voffB); PG8_STAGE(PG8_SA(0, 0), cA, voffA); PG8_STAGE(PG8_SA(0, 1), cA + hstep, voffA);
        if (wr == 1) PG8_BAR;
        PG8_WAIT_V(2); PG8_BAR;
        PG8_STAGE(PG8_SB(1, 0), cB + kstep, voffB); PG8_STAGE(PG8_SA(1, 0), cA + kstep, voffA); PG8_STAGE(PG8_SB(1, 1), cB + hstep + kstep, voffB);
        PG8_WAIT_V(6); PG8_BAR;
    } else {
        PG8_STAGE(PG8_SB(0, 0), cB, voffB); PG8_STAGE(PG8_SA(0, 0), cA, voffA); PG8_STAGE(PG8_SB(0, 1), cB + hstep, voffB); PG8_STAGE(PG8_SA(0, 1), cA + hstep, voffA);
        if (wr == 1) PG8_BAR;
        PG8_WAIT_V(4); PG8_BAR;
        PG8_STAGE(PG8_SB(1, 0), cB + kstep, voffB); PG8_STAGE(PG8_SA(1, 0), cA + kstep, voffA); PG8_STAGE(PG8_SB(1, 1), cB + hstep + kstep, voffB);
        PG8_WAIT_V(6); PG8_BAR;
    }
    for (;;) {
        const bool has_next = S.next(ui + 1, nxt);
        const char* nA = has_next ? (const char*)g.A + (size_t)nxt.pm * tstep : cA; const char* nB = has_next ? (const char*)g.Bt + (size_t)nxt.pn * tstep : cB;
        for (int t = 0; t < nt; t += 2) {
            const bool last = (t == nt - 2);
            const char* a1 = cA + (size_t)(t + 1) * kstep;
            const char* a2 = last ? nA : cA + (size_t)(t + 2) * kstep; const char* b2 = last ? nB : cB + (size_t)(t + 2) * kstep;
            const char* a3 = a2 + kstep; const char* b3 = b2 + kstep;
            if (last && has_next) S.a_ready(nxt);
            if constexpr (SP2) {
            PG8_LDB(B0, 0, 0); PG8_LDB(B1, 0, 1); PG8_SCHED; PG8_LDA(At, 0, 0); PG8_STAGE(PG8_SA(1, 1), a1 + hstep, voffA);
            PG8_WAIT_V(8); PG8_WAIT_L(0); PG8_BAR; PG8_MMA(0, 0, At, B0); PG8_MMA(0, 1, At, B1); PG8_BAR; PG8_SCHED;
            PG8_LDA(At, 0, 1); PG8_STAGE(PG8_SB(0, 0), b2, voffB); PG8_STAGE(PG8_SB(0, 1), b2 + hstep, voffB); PG8_STAGE(PG8_SA(0, 0), a2, voffA);
            PG8_WAIT_V(8); PG8_WAIT_L(0); PG8_BAR; PG8_MMA(1, 0, At, B0); PG8_MMA(1, 1, At, B1); PG8_BAR; PG8_SCHED;
            PG8_LDB(B0, 1, 0); PG8_LDB(B1, 1, 1); PG8_SCHED; PG8_LDA(At, 1, 0); PG8_STAGE(PG8_SA(0, 1), a2 + hstep, voffA);
            PG8_WAIT_V(8); PG8_WAIT_L(0); PG8_BAR; PG8_MMA(0, 0, At, B0); PG8_MMA(0, 1, At, B1); PG8_BAR; PG8_SCHED;
            PG8_LDA(At, 1, 1); PG8_STAGE(PG8_SB(1, 0), b3, voffB); PG8_STAGE(PG8_SB(1, 1), b3 + hstep, voffB); PG8_STAGE(PG8_SA(1, 0), a3, voffA);
            PG8_WAIT_V(8); PG8_WAIT_L(0); PG8_BAR; PG8_MMA(1, 0, At, B0); PG8_MMA(1, 1, At, B1); PG8_BAR; PG8_SCHED;
            } else {
            PG8_LDB(B0, 0, 0); PG8_SCHED; PG8_LDA(At, 0, 0); PG8_STAGE(PG8_SA(1, 1), a1 + hstep, voffA);
            PG8_WAIT_L(8); PG8_BAR; PG8_WAIT_L(0); PG8_MMA(0, 0, At, B0); PG8_BAR; PG8_SCHED;
            PG8_LDB(B1, 0, 1); PG8_STAGE(PG8_SB(0, 0), b2, voffB);
            PG8_BAR; PG8_WAIT_L(0); PG8_MMA(0, 1, At, B1); PG8_BAR;
            PG8_LDA(At, 0, 1); PG8_STAGE(PG8_SA(0, 0), a2, voffA);
            PG8_BAR; PG8_WAIT_L(0); PG8_MMA(1, 0, At, B0); PG8_BAR; PG8_SCHED;
            PG8_STAGE(PG8_SB(0, 1), b2 + hstep, voffB);
            PG8_WAIT_V(6); PG8_BAR; PG8_MMA(1, 1, At, B1); PG8_BAR;
            PG8_LDB(B0, 1, 0); PG8_SCHED; PG8_LDA(At, 1, 0); PG8_STAGE(PG8_SA(0, 1), a2 + hstep, voffA);
            PG8_WAIT_L(8); PG8_BAR; PG8_WAIT_L(0); PG8_MMA(0, 0, At, B0); PG8_BAR; PG8_SCHED;
            PG8_LDB(B1, 1, 1); PG8_STAGE(PG8_SB(1, 0), b3, voffB);
            PG8_BAR; PG8_WAIT_L(0); PG8_MMA(0, 1, At, B1); PG8_BAR;
            PG8_LDA(At, 1, 1); PG8_STAGE(PG8_SA(1, 0), a3, voffA);
            PG8_BAR; PG8_WAIT_L(0); PG8_MMA(1, 0, At, B0); PG8_BAR; PG8_SCHED;
            PG8_STAGE(PG8_SB(1, 1), b3 + hstep, voffB);
            PG8_WAIT_V(6); PG8_BAR; PG8_MMA(1, 1, At, B1); PG8_BAR;
            }
        }
        if constexpr (ALIGN_EPI) { if (wr == 0) PG8_BAR; }
        if constexpr (!Epi::AFTER_DRAIN) { E(acc, cur, wr, wc, fr, fq); S.done(cur); }
        if (!has_next) break;
#pragma unroll
        for (int a = 0; a < 2; ++a)
#pragma unroll
            for (int b = 0; b < 2; ++b)
#pragma unroll
                for (int m = 0; m < 4; ++m)
#pragma unroll
                    for (int n = 0; n < 2; ++n) acc[a][b][m][n] = (f32x4){0.f, 0.f, 0.f, 0.f};
        cur = nxt; cA = nA; cB = nB; ++ui;
        if constexpr (ALIGN_EPI) { if (wr == 1) PG8_BAR; }
    }
    PG8_WAIT_V(0);
    if constexpr (!ALIGN_EPI) { if (wr == 0) PG8_BAR; }
    PG8_BAR;
    if constexpr (Epi::AFTER_DRAIN) { E.fused(acc, cur, wr, wc, fr, fq, lds, wid, lane); S.done(cur); }
#undef PG8_SA
#undef PG8_SB
#undef PG8_STAGE
#undef PG8_LDA
#undef PG8_LDB
#undef PG8_MMA
#undef PG8_WAIT_V
#undef PG8_WAIT_L
#undef PG8_BAR
#undef PG8_SCHED
}
}
constexpr int NWAVES = 8;
constexpr int BATCH = 8, SEQ = 4096, D = 1024, M = BATCH * SEQ;
constexpr int DFF = 2816, NGU = 2 * DFF, DRW = 512, DCV = 512, NH = 8, HS = 64;
constexpr int DSHIFT = 3 * DRW + 64 + 64 + 128;
constexpr int DIN = DSHIFT + 2 * DCV;
constexpr int CONVW = 31;
constexpr float RMS_EPS = 1e-6f, GN_EPS = 64e-5f, LN_EPS = 1e-5f, DECAY_SCALE = 0.60653065971f;
#ifndef MK_ONE_LAUNCH
#define MK_ONE_LAUNCH 1
#endif
constexpr int N_PHASES = 12;

constexpr size_t MiB = 1u << 20;
constexpr size_t WS_CTL = 0, CTL_ZERO_BYTES = 1 * MiB;
constexpr size_t WS_WGU1 = 2 * MiB, WS_WDN1 = 13 * MiB, WS_WIN = 19 * MiB, WS_WOUT = 25 * MiB, WS_WGU2 = 27 * MiB, WS_WDN2 = 38 * MiB;
constexpr size_t WS_XN = 48 * MiB;
constexpr size_t WS_H = 112 * MiB;
constexpr size_t WS_F = 288 * MiB;
constexpr size_t WS_OAB = 416 * MiB;
constexpr size_t WS_END = 480 * MiB;
static_assert(WS_WGU1 + (size_t)NGU * D * 2 <= WS_WDN1 && WS_WDN1 + (size_t)D * DFF * 2 <= WS_WIN && WS_WIN + (size_t)DIN * D * 2 <= WS_WOUT && WS_WOUT + (size_t)D * D * 2 <= WS_WGU2 &&
              WS_WGU2 + (size_t)NGU * D * 2 <= WS_WDN2 && WS_WDN2 + (size_t)D * DFF * 2 <= WS_XN && WS_XN + (size_t)M * D * 2 <= WS_H && WS_H + (size_t)M * DFF * 2 <= WS_F &&
              WS_F + (size_t)M * D * 4 <= WS_OAB && WS_OAB + (size_t)M * D * 2 <= WS_END, "d_ws map");
constexpr size_t WS_LORA = 44 * MiB;
constexpr size_t WS_MT = WS_XN, WS_NT = WS_XN + 32 * MiB, WS_RZ = WS_F, WS_Y0 = WS_F + 32 * MiB, WS_GB = WS_F + 64 * MiB, WS_BON = WS_F + 96 * MiB;
constexpr int NCH = SEQ / 64;
constexpr int CW_TMO = 0, CW_CODE = 1;
constexpr int CW_BAR = 4096;

constexpr int RING_OFF = 0, RING_BYTES = 147456;
constexpr int LDSCTL_OFF = RING_BYTES, MISC_OFF = LDSCTL_OFF + 320;
constexpr int LDS_BYTES = 148480;
static_assert(MISC_OFF + 128 <= LDS_BYTES, "LDS map");
#define GAS __attribute__((address_space(1)))
#define LAS __attribute__((address_space(3)))
typedef unsigned short bf16;
typedef unsigned v4u __attribute__((ext_vector_type(4)));
typedef float f32x4 __attribute__((ext_vector_type(4)));
typedef short bf16x8 __attribute__((ext_vector_type(8)));
typedef GAS unsigned gu32;
typedef GAS unsigned long long gu64;
#define RLX_AGENT __ATOMIC_RELAXED, __HIP_MEMORY_SCOPE_AGENT
#define LDS_WAIT() asm volatile("s_waitcnt lgkmcnt(0)" ::: "memory")
#define VM_WAIT() asm volatile("s_waitcnt vmcnt(0)" ::: "memory")
__device__ __forceinline__ unsigned long long rt() { return __builtin_amdgcn_s_memrealtime(); }
__device__ __forceinline__ unsigned f2bf(float f) { unsigned u = __builtin_bit_cast(unsigned, f); return (u + 0x7fffu + ((u >> 16) & 1u)) >> 16; }
__device__ __forceinline__ unsigned pk2(float lo, float hi) { return f2bf(lo) | (f2bf(hi) << 16); }
#define XB_TMO      128
#define XB_XCNT(j)  (256  + 64 * (j))
#define XB_XSUB(j)  (1280 + 64 * (j))
#define XB_XGEN(j)  (2304 + 64 * (j))
#define XB_TOP      3328
#define XB_TOPGEN   3392
#define XCD_BAR_WORDS 3456
#define XB_SPIN_CAP (1u << 18)

__device__ __forceinline__ unsigned xb_ld(unsigned* p)              { return __hip_atomic_load(p, __ATOMIC_RELAXED, __HIP_MEMORY_SCOPE_AGENT); }
__device__ __forceinline__ unsigned xb_add(unsigned* p, unsigned v) { return __hip_atomic_fetch_add(p, v, __ATOMIC_RELAXED, __HIP_MEMORY_SCOPE_AGENT); }
__device__ __forceinline__ unsigned xb_xcc_id() { return (unsigned)__builtin_amdgcn_s_getreg((3 << 11) | 20) & 0xFu; }
#define XB_SPIN(cond, bar) do { unsigned _sp = 0; while (cond) { __builtin_amdgcn_s_sleep(1); \
    if ((++_sp & 255u) == 0u) { if (xb_ld(&(bar)[XB_TMO])) break; if (_sp > XB_SPIN_CAP) { atomicAdd(&(bar)[XB_TMO], 1u); break; } } } } while (0)

struct XcdBarrier {
    unsigned* bar; unsigned x;
    volatile LAS unsigned* st;
};

__device__ __forceinline__ XcdBarrier xcd_barrier_post(unsigned* bar, volatile LAS unsigned* st) {
    XcdBarrier b; b.bar = bar; b.x = xb_xcc_id(); b.st = st;
    if (threadIdx.x == 0) (void)xb_add(&bar[XB_XCNT(b.x)], 1u);
    return b;
}
__device__ __forceinline__ void xcd_barrier_complete(unsigned* bar, unsigned x, unsigned& nloc, unsigned& nx) {
    const unsigned G = gridDim.x * gridDim.y * gridDim.z;
    unsigned sum, cnt, mine, sp = 0u;
    for (;;) {
        sum = 0u; cnt = 0u; mine = 0u;
#pragma unroll
        for (unsigned j = 0; j < 16; ++j) { const unsigned c = xb_ld(&bar[XB_XCNT(j)]); sum += c; cnt += (c > 0u) ? 1u : 0u; mine = (j == x) ? c : mine; }
        if (sum == G) break;
        __builtin_amdgcn_s_sleep(1);
        if ((++sp & 255u) == 0u) { if (xb_ld(&bar[XB_TMO])) break; if (sp > XB_SPIN_CAP) { atomicAdd(&bar[XB_TMO], 1u); break; } }
    }
    nloc = mine > 0u ? mine : 1u; nx = cnt > 0u ? cnt : 1u;
}

__device__ __forceinline__ void xcd_barrier(const XcdBarrier& b) {
    asm volatile("s_waitcnt vmcnt(0)" ::: "memory");
    __syncthreads();
    if (threadIdx.x == 0) {
        unsigned* bar = b.bar;
        __builtin_amdgcn_s_waitcnt(0);
        unsigned nloc = b.st[0], nx = b.st[1];
        if (nloc == 0u) { xcd_barrier_complete(bar, b.x, nloc, nx); b.st[0] = nloc; b.st[1] = nx; }
        const unsigned old = xb_add(&bar[XB_XSUB(b.x)], 1u);
        const unsigned gen = old / nloc;
        if (old + 1u == (gen + 1u) * nloc) {
            __builtin_amdgcn_fence(__ATOMIC_RELEASE, "agent");
            asm volatile("s_waitcnt vmcnt(0)" ::: "memory");
            const unsigned og = xb_add(&bar[XB_TOP], 1u);
            const unsigned tg = og / nx;
            if (og + 1u == (tg + 1u) * nx) xb_add(&bar[XB_TOPGEN], 1u);
            else XB_SPIN(xb_ld(&bar[XB_TOPGEN]) == tg, bar);
            __builtin_amdgcn_fence(__ATOMIC_ACQUIRE, "agent");
            xb_add(&bar[XB_XGEN(b.x)], 1u);
            asm volatile("s_waitcnt vmcnt(0)" ::: "memory");
        } else {
            XB_SPIN(xb_ld(&bar[XB_XGEN(b.x)]) == gen, bar);
            __builtin_amdgcn_fence(__ATOMIC_ACQUIRE, "agent");
            asm volatile("s_waitcnt vmcnt(0)" ::: "memory");
        }
    }
    __syncthreads();
}
struct Frame {
    LAS unsigned char* lds;
    volatile LAS unsigned* MISC;
    gu32* ctl; unsigned char* ws;
    int tid, lane, wave;
    int vcu, G;
    const float* in[28]; float* out;
    bf16 *Wgu1, *Wdn1, *Win, *Wout, *Wgu2, *Wdn2;
    bf16 *XN, *H, *OAB; float* Fm;
};
enum { I_X = 0, I_F1PRE, I_F1POST, I_F1GU, I_F1DN, I_MPRE, I_MPOST, I_WIN, I_MU, I_WUP, I_W0, I_AUP, I_A0, I_GUP, I_KK, I_KA, I_RK, I_GNW, I_GNB, I_CDW, I_CB, I_CLW, I_CLB, I_WOUT, I_F2PRE, I_F2POST, I_F2GU, I_F2DN };

__device__ __forceinline__ float wave_sum(float v) {
#pragma unroll
    for (int o = 1; o < 64; o <<= 1) v += __shfl_xor(v, o);
    return v;
}
__device__ __forceinline__ float bf2f(bf16 v) { return __uint_as_float(((unsigned)v) << 16); }
__device__ __forceinline__ float sigm(float x) { return 1.0f / (1.0f + __expf(-x)); }

__device__ __forceinline__ void p0_transpose_item(const float* W, int K, int N, bf16* WT, int gu, LAS float* scr, int item, int lane) {
    const int nblk = N / 32, kb = item / nblk, nb = item % nblk, k0 = 64 * kb, n0 = 32 * nb;
    int r0 = n0;
    if (gu) { const int up = n0 >= DFF ? 1 : 0, nn = n0 - up * DFF; r0 = (nn >> 7) * 256 + up * 128 + (nn & 127); }
#pragma unroll 8
    for (int i = 0; i < 32; ++i) { const int kk = 2 * i + (lane >> 5); scr[kk * 33 + (lane & 31)] = W[(size_t)(k0 + kk) * N + n0 + (lane & 31)]; }
    LDS_WAIT(); asm volatile("" ::: "memory");
    const int c = lane & 7;
#pragma unroll
    for (int j = 0; j < 4; ++j) { const int n = (lane >> 3) + 8 * j; const LAS float* s = scr + (8 * c) * 33 + n;
        v4u o; o.x = pk2(s[0 * 33], s[1 * 33]); o.y = pk2(s[2 * 33], s[3 * 33]); o.z = pk2(s[4 * 33], s[5 * 33]); o.w = pk2(s[6 * 33], s[7 * 33]);
        *(GAS v4u*)(WT + (size_t)(r0 + n) * K + k0 + 8 * c) = o; }
    LDS_WAIT(); asm volatile("" ::: "memory");
}
__device__ __forceinline__ void rms_row_to_bf16(Frame& F, const float* xrow, const float* g, bf16* orow) {
    const GAS f32x4* xr = (const GAS f32x4*)xrow + F.lane; const GAS f32x4* gr = (const GAS f32x4*)g + F.lane;
    f32x4 v[4]; float s = 0.f;
#pragma unroll
    for (int j = 0; j < 4; ++j) { v[j] = xr[64 * j]; s += (v[j].x * v[j].x + v[j].y * v[j].y) + (v[j].z * v[j].z + v[j].w * v[j].w); }
    const float r = 1.0f / sqrtf(wave_sum(s) * (1.f / D) + RMS_EPS);
    GAS unsigned long long* o8 = (GAS unsigned long long*)orow + F.lane;
#pragma unroll
    for (int j = 0; j < 4; ++j) { const f32x4 gg = gr[64 * j]; o8[64 * j] = (unsigned long long)pk2(v[j].x * r * gg.x, v[j].y * r * gg.y) | ((unsigned long long)pk2(v[j].z * r * gg.z, v[j].w * r * gg.w) << 32); }
}
__device__ __forceinline__ void p0_prologue(Frame& F) {
    LAS float* scr = (LAS float*)(F.lds + RING_OFF + F.wave * 16384);
    const int gw = F.vcu * NWAVES + F.wave, NGW = F.G * NWAVES;
    constexpr int I_GU = (D / 64) * (NGU / 32), I_DN = (DFF / 64) * (D / 32), I_IN = (D / 64) * (DIN / 32), I_OUT = (D / 64) * (D / 32);
    constexpr int NITEMS = 2 * I_GU + 2 * I_DN + I_IN + I_OUT + 16 + 16 + 32;
    for (int it = gw; it < NITEMS; it += NGW) {
        int r = it;
        if (r < I_GU) { p0_transpose_item(F.in[I_F1GU], D, NGU, F.Wgu1, 1, scr, r, F.lane); continue; } r -= I_GU;
        if (r < I_GU) { p0_transpose_item(F.in[I_F2GU], D, NGU, F.Wgu2, 1, scr, r, F.lane); continue; } r -= I_GU;
        if (r < I_DN) { p0_transpose_item(F.in[I_F1DN], DFF, D, F.Wdn1, 0, scr, r, F.lane); continue; } r -= I_DN;
        if (r < I_DN) { p0_transpose_item(F.in[I_F2DN], DFF, D, F.Wdn2, 0, scr, r, F.lane); continue; } r -= I_DN;
        if (r < I_IN) { p0_transpose_item(F.in[I_WIN], D, DIN, F.Win, 0, scr, r, F.lane); continue; } r -= I_IN;
        if (r < I_OUT) { p0_transpose_item(F.in[I_WOUT], D, D, F.Wout, 0, scr, r, F.lane); continue; } r -= I_OUT;
        bf16* lora = (bf16*)(F.ws + WS_LORA);
        if (r < 16) { p0_transpose_item(F.in[I_WUP], 64, DRW, lora, 0, scr, r, F.lane); continue; } r -= 16;
        if (r < 16) { p0_transpose_item(F.in[I_AUP], 64, DRW, lora + 512 * 64, 0, scr, r, F.lane); continue; } r -= 16;
        p0_transpose_item(F.in[I_GUP], 128, DRW, lora + 2 * 512 * 64, 0, scr, r, F.lane);
    }
    for (int m = gw; m < M; m += NGW) rms_row_to_bf16(F, F.in[I_X] + (size_t)m * D, F.in[I_F1PRE], F.XN + (size_t)m * D);
}
__device__ __forceinline__ void norm_pass(Frame& F, const float* Fm, const float* base, float* out, const float* gpost, float scale, const float* gpre, bf16* xn) {
    const int gw = F.vcu * NWAVES + F.wave, NGW = F.G * NWAVES;
    for (int m = gw; m < M; m += NGW) {
        const GAS f32x4* fr = (const GAS f32x4*)(Fm + (size_t)m * D) + F.lane; const GAS f32x4* br = (const GAS f32x4*)(base + (size_t)m * D) + F.lane;
        const GAS f32x4* gp = (const GAS f32x4*)gpost + F.lane;
        f32x4 f[4], o[4]; float s = 0.f;
#pragma unroll
        for (int j = 0; j < 4; ++j) { f[j] = fr[64 * j]; o[j] = br[64 * j]; s += (f[j].x * f[j].x + f[j].y * f[j].y) + (f[j].z * f[j].z + f[j].w * f[j].w); }
        const float r = scale / sqrtf(wave_sum(s) * (1.f / D) + RMS_EPS);
        float s2 = 0.f;
#pragma unroll
        for (int j = 0; j < 4; ++j) { const f32x4 g = gp[64 * j]; o[j] = o[j] + f[j] * r * g; s2 += (o[j].x * o[j].x + o[j].y * o[j].y) + (o[j].z * o[j].z + o[j].w * o[j].w); }
        GAS f32x4* orow = (GAS f32x4*)(out + (size_t)m * D) + F.lane;
#pragma unroll
        for (int j = 0; j < 4; ++j) orow[64 * j] = o[j];
        if (xn) {
            const float r2 = 1.0f / sqrtf(wave_sum(s2) * (1.f / D) + RMS_EPS);
            const GAS f32x4* gq = (const GAS f32x4*)gpre + F.lane;
            GAS unsigned long long* o8 = (GAS unsigned long long*)(xn + (size_t)m * D) + F.lane;
#pragma unroll
            for (int j = 0; j < 4; ++j) { const f32x4 gg = gq[64 * j]; o8[64 * j] = (unsigned long long)pk2(o[j].x * r2 * gg.x, o[j].y * r2 * gg.y) | ((unsigned long long)pk2(o[j].z * r2 * gg.z, o[j].w * r2 * gg.w) << 32); }
        }
    }
}

__device__ __forceinline__ void conv_unit(Frame& F, const bf16* P, int unit) {
    const int b = unit / (SEQ / 32), t0 = (unit % (SEQ / 32)) * 32, c = F.tid;
    LAS float* sG = (LAS float*)(F.lds + RING_OFF);
    LAS float* sRed = sG + 62 * 512;
    for (int rr = 0; rr < 62; ++rr) { const int t = t0 - 30 + rr; float v = 0.f;
        if (t >= 0) { const bf16* pr = P + (size_t)(b * SEQ + t) * DIN + DSHIFT; const float a = bf2f(pr[c]), g = bf2f(pr[DCV + c]); v = a * sigm(g); }
        sG[rr * 512 + c] = v; }
    float w[CONVW];
#pragma unroll
    for (int j = 0; j < CONVW; ++j) w[j] = F.in[I_CDW][j * DCV + c];
    const float cb = F.in[I_CB][c], lw = F.in[I_CLW][c], lb = F.in[I_CLB][c];
#pragma unroll 1
    for (int tt = 0; tt < 32; ++tt) { float a = cb;
#pragma unroll
        for (int j = 0; j < CONVW; ++j) a += w[j] * sG[(tt + j) * 512 + c];
        sG[tt * 512 + c] = a;
        const float s = wave_sum(a); if (F.lane == 0) sRed[tt * 8 + F.wave] = s; }
    __syncthreads();
#pragma unroll 1
    for (int tt = 0; tt < 32; ++tt) { float s = 0.f;
#pragma unroll
        for (int k = 0; k < 8; ++k) s += sRed[tt * 8 + k];
        sG[tt * 512 + c] -= s * (1.f / DCV); }
    __syncthreads();
#pragma unroll 1
    for (int tt = 0; tt < 32; ++tt) { const float d = sG[tt * 512 + c]; const float s = wave_sum(d * d); if (F.lane == 0) sRed[tt * 8 + F.wave] = s; }
    __syncthreads();
#pragma unroll 1
    for (int tt = 0; tt < 32; ++tt) { float s = 0.f;
#pragma unroll
        for (int k = 0; k < 8; ++k) s += sRed[tt * 8 + k];
        const float v = sG[tt * 512 + c] * (1.0f / sqrtf(s * (1.f / DCV) + LN_EPS)) * lw + lb;
        F.OAB[(size_t)(b * SEQ + t0 + tt) * D + DRW + c] = (bf16)f2bf(v * sigm(v)); }
    __syncthreads();
}

constexpr int LS = 72;
constexpr int SLOT = 64 * LS * 2;
constexpr int O_RT = 0, O_ZT = SLOT, O_BT = 2 * SLOT, O_KT = 3 * SLOT, O_ZTT = 4 * SLOT, O_VT = 5 * SLOT, O_BHT = 6 * SLOT, O_KHT = 7 * SLOT;
constexpr int O_U0T = O_ZT, O_X1T = O_BT, O_WZT = O_KT;
constexpr int O_LZK = 8 * SLOT, O_LRB = 9 * SLOT, O_LRK = 10 * SLOT, O_TL = 11 * SLOT;
constexpr int LTS = 68;
constexpr int O_LT = 12 * SLOT;
constexpr int SS = 40;
constexpr int O_L10 = O_LT + 64 * LTS * 4, O_T00T = O_L10 + 32 * SS * 2, O_XT = O_T00T + 64 * SS * 2, O_PC = O_XT + 32 * SS * 2, O_TOT = O_PC + 256, O_AEND = O_TOT + 2048;
constexpr int O_LDF = 0, O_AAF = 64 * 65 * 4;
constexpr int O_TX = 8 * SLOT, O_XA = 9 * SLOT, O_SG = 10 * SLOT;
constexpr int SGS = 136;
static_assert(O_AAF + 64 * 65 * 4 <= 8 * SLOT && O_SG + 64 * SGS * 2 <= O_LT && O_AEND <= RING_BYTES, "rwkv LDS map");

typedef float f32x4v __attribute__((ext_vector_type(4)));
__device__ __forceinline__ f32x4 mfma16(bf16x8 a, bf16x8 b, f32x4 c) { return __builtin_amdgcn_mfma_f32_16x16x32_bf16(a, b, c, 0, 0, 0); }
__device__ __forceinline__ f32x4 mm16(const LAS bf16* A, int lda, const LAS bf16* B, int ldb, int tm, int tn, int nks, int lane, f32x4 acc) {
    const LAS bf16* ap = A + (16 * tm + (lane & 15)) * lda + 8 * (lane >> 4);
    const LAS bf16* bp = B + (16 * tn + (lane & 15)) * ldb + 8 * (lane >> 4);
#pragma unroll
    for (int ks = 0; ks < 2; ++ks) if (ks < nks) acc = mfma16(*(const LAS bf16x8*)(ap + 32 * ks), *(const LAS bf16x8*)(bp + 32 * ks), acc);
    return acc;
}
typedef unsigned u32x2 __attribute__((ext_vector_type(2)));
__device__ __forceinline__ u32x2 pack4(f32x4 v) { u32x2 r; r.x = pk2(v[0], v[1]); r.y = pk2(v[2], v[3]); return r; }
__device__ __forceinline__ void wr_nat(LAS bf16* W, int ldw, int tm, int tn, int lane, f32x4 v) { *(LAS u32x2*)(W + (16 * tn + (lane & 15)) * ldw + 16 * tm + 4 * (lane >> 4)) = pack4(v); }
__device__ __forceinline__ float fast_tanh(float x) { const float e = __expf(2.0f * x); return 1.0f - 2.0f / (e + 1.0f); }
#define WG_BAR() do { asm volatile("s_waitcnt vmcnt(0) lgkmcnt(0)" ::: "memory"); __builtin_amdgcn_s_barrier(); asm volatile("" ::: "memory"); } while (0)

#define LAUNDER_IDX() int lane = lane0, w = w0; asm volatile("" : "+v"(lane)); asm volatile("" : "+s"(w)); const int q4 = lane >> 4, l15 = lane & 15; (void)q4; (void)l15
__device__ __forceinline__ void rwkv_prep_unit(Frame& F, const bf16* P, int b, int c, int h) {
    const int lane0 = F.lane, w0 = F.wave;
    LAS unsigned char* L = F.lds + RING_OFF;
    LAS bf16* Rt = (LAS bf16*)(L + O_RT); LAS bf16* Zt = (LAS bf16*)(L + O_ZT); LAS bf16* Bt = (LAS bf16*)(L + O_BT); LAS bf16* Kt = (LAS bf16*)(L + O_KT);
    LAS bf16* ZtT = (LAS bf16*)(L + O_ZTT); LAS bf16* VT = (LAS bf16*)(L + O_VT); LAS bf16* BhT = (LAS bf16*)(L + O_BHT); LAS bf16* KhT = (LAS bf16*)(L + O_KHT);
    LAS bf16* U0T = (LAS bf16*)(L + O_U0T); LAS bf16* X1T = (LAS bf16*)(L + O_X1T); LAS bf16* WzT = (LAS bf16*)(L + O_WZT);
    LAS bf16* Lzk = (LAS bf16*)(L + O_LZK); LAS bf16* Lrb = (LAS bf16*)(L + O_LRB); LAS bf16* Lrk = (LAS bf16*)(L + O_LRK); LAS bf16* Tl = (LAS bf16*)(L + O_TL);
    LAS float* LT = (LAS float*)(L + O_LT); LAS bf16* L10 = (LAS bf16*)(L + O_L10); LAS bf16* T00T = (LAS bf16*)(L + O_T00T); LAS bf16* XT = (LAS bf16*)(L + O_XT);
    LAS float* PCv = (LAS float*)(L + O_PC); LAS float* TOT = (LAS float*)(L + O_TOT);
    LAS float* LDf = (LAS float*)(L + O_LDF); LAS float* AAf = (LAS float*)(L + O_AAF);
    LAS bf16* TX = (LAS bf16*)(L + O_TX); LAS bf16* XA = (LAS bf16*)(L + O_XA); LAS bf16* SG = (LAS bf16*)(L + O_SG);
    unsigned char* ws = (unsigned char*)F.ctl;
    const bf16* WupT = (const bf16*)(ws + WS_LORA); const bf16* AupT = WupT + 512 * 64; const bf16* GupT = AupT + 512 * 64;
    const int unit = (b * NH + h) * NCH + c;
    bf16* MTg = (bf16*)(ws + WS_MT) + (size_t)unit * 4096; bf16* NTg = (bf16*)(ws + WS_NT) + (size_t)unit * 4096;
    bf16* RZg = (bf16*)(ws + WS_RZ) + (size_t)unit * 4096; bf16* Y0g = (bf16*)(ws + WS_Y0) + (size_t)unit * 4096;
    bf16* GBg = (bf16*)(ws + WS_GB); float* BONg = (float*)(ws + WS_BON);
    const int tl0 = c * 64;
    const size_t tg0 = (size_t)b * SEQ + tl0;

    float rr[8], kx[8], vv[8];
    {
        LAUNDER_IDX();
        const int cols[7] = {h * 64 + lane, DRW + h * 64 + lane, 2 * DRW + h * 64 + lane, 3 * DRW + lane, 3 * DRW + 64 + lane, 3 * DRW + 128 + lane, 3 * DRW + 192 + lane};
#pragma unroll
        for (int g = 0; g < 7; ++g) {
            const float mu = F.in[I_MU][cols[g]];
            const bf16* pc = P + (tg0 + 8 * w) * DIN + cols[g];
            float prev = (tl0 + 8 * w > 0) ? bf2f(pc[-(long)DIN]) : 0.f;
#pragma unroll
            for (int i = 0; i < 8; ++i) {
                const float cur = bf2f(pc[(size_t)i * DIN]); const float v = cur + (prev - cur) * mu; prev = cur;
                if (g == 0) rr[i] = v; else if (g == 1) kx[i] = v; else if (g == 2) vv[i] = v;
                else if (g == 3) TX[(8 * w + i) * LS + lane] = (bf16)f2bf(fast_tanh(v));
                else if (g == 4) XA[(8 * w + i) * LS + lane] = (bf16)f2bf(v);
                else SG[(8 * w + i) * SGS + (g - 5) * 64 + lane] = (bf16)f2bf(sigm(v));
            }
        }
    }
    WG_BAR();
    {
        LAUNDER_IDX();
        const int tm = w >> 1;
#pragma unroll
        for (int tt = 0; tt < 2; ++tt) { const int tn = 2 * (w & 1) + tt; const int j = 16 * tn + l15, gj = h * 64 + j;
            f32x4 aD = {0.f, 0.f, 0.f, 0.f}, aA = aD, aG = aD;
            const LAS bf16* txp = TX + (16 * tm + l15) * LS + 8 * q4; const LAS bf16* xap = XA + (16 * tm + l15) * LS + 8 * q4; const LAS bf16* sgp = SG + (16 * tm + l15) * SGS + 8 * q4;
            const bf16* wu = WupT + (size_t)gj * 64 + 8 * q4; const bf16* au = AupT + (size_t)gj * 64 + 8 * q4; const bf16* gu = GupT + (size_t)gj * 128 + 8 * q4;
#pragma unroll
            for (int ks = 0; ks < 2; ++ks) { aD = mfma16(*(const LAS bf16x8*)(txp + 32 * ks), *(const GAS bf16x8*)(wu + 32 * ks), aD); aA = mfma16(*(const LAS bf16x8*)(xap + 32 * ks), *(const GAS bf16x8*)(au + 32 * ks), aA); }
#pragma unroll
            for (int ks = 0; ks < 4; ++ks) aG = mfma16(*(const LAS bf16x8*)(sgp + 32 * ks), *(const GAS bf16x8*)(gu + 32 * ks), aG);
            const float w0j = F.in[I_W0][gj], a0j = F.in[I_A0][gj];
#pragma unroll
            for (int r = 0; r < 4; ++r) { const int t = 16 * tm + 4 * q4 + r;
                LDf[t * 65 + j] = -DECAY_SCALE * sigm(aD[r] + w0j); AAf[t * 65 + j] = sigm(aA[r] + a0j);
                GBg[(tg0 + t) * DRW + gj] = (bf16)f2bf(aG[r]); }
        }
    }
    WG_BAR();
    {
        LAUNDER_IDX();
        const int hj = h * 64 + lane;
        float ld[8], aa[8], cl[8];
#pragma unroll
        for (int i = 0; i < 8; ++i) { ld[i] = LDf[(8 * w + i) * 65 + lane]; aa[i] = AAf[(8 * w + i) * 65 + lane]; }
        cl[0] = ld[0];
#pragma unroll
        for (int i = 1; i < 8; ++i) cl[i] = cl[i - 1] + ld[i];
        TOT[w * 64 + lane] = cl[7];
        const float kkj = F.in[I_KK][hj], kaj = F.in[I_KA][hj], rkj = F.in[I_RK][hj];
        float kn[8], kp[8];
#pragma unroll
        for (int i = 0; i < 8; ++i) { const float kr = kx[i] * kkj; const float ss = wave_sum(kr * kr); kn[i] = kr * (1.0f / sqrtf(fmaxf(ss, 1e-12f)));
            kp[i] = kx[i] * (1.0f + (aa[i] - 1.0f) * kaj);
            const float bon = wave_sum(rr[i] * kp[i] * rkj); if (lane == 0) BONg[(tg0 + 8 * w + i) * NH + h] = bon; }
        WG_BAR();
        float off = 0.f, tot = 0.f;
#pragma unroll
        for (int k = 0; k < 8; ++k) { const float tv = TOT[k * 64 + lane]; tot += tv; if (k < w) off += tv; }
        float zt[8], bh[8], kh[8];
#pragma unroll
        for (int i = 0; i < 8; ++i) { const float cli = cl[i] + off; const float eL = __expf(cli), eLm = __expf(cli - ld[i]), ieL = __expf(-cli), eC = __expf(tot - cli);
            const float ka = kn[i] * aa[i]; const int t = 8 * w + i;
            zt[i] = -kn[i] * eLm; bh[i] = ka * eC; kh[i] = kp[i] * eC;
            Rt[t * LS + lane] = (bf16)f2bf(rr[i] * eL); Zt[t * LS + lane] = (bf16)f2bf(zt[i]); Bt[t * LS + lane] = (bf16)f2bf(ka * ieL); Kt[t * LS + lane] = (bf16)f2bf(kp[i] * ieL); }
        v4u o;
        o.x = pk2(zt[0], zt[1]); o.y = pk2(zt[2], zt[3]); o.z = pk2(zt[4], zt[5]); o.w = pk2(zt[6], zt[7]); *(LAS v4u*)(ZtT + lane * LS + 8 * w) = o;
        o.x = pk2(vv[0], vv[1]); o.y = pk2(vv[2], vv[3]); o.z = pk2(vv[4], vv[5]); o.w = pk2(vv[6], vv[7]); *(LAS v4u*)(VT + lane * LS + 8 * w) = o;
        o.x = pk2(bh[0], bh[1]); o.y = pk2(bh[2], bh[3]); o.z = pk2(bh[4], bh[5]); o.w = pk2(bh[6], bh[7]); *(LAS v4u*)(BhT + lane * LS + 8 * w) = o;
        o.x = pk2(kh[0], kh[1]); o.y = pk2(kh[2], kh[3]); o.z = pk2(kh[4], kh[5]); o.w = pk2(kh[6], kh[7]); *(LAS v4u*)(KhT + lane * LS + 8 * w) = o;
        if (w == 0) PCv[lane] = __expf(tot);
    }
    WG_BAR();
    {
    LAUNDER_IDX();
#pragma unroll 1
    for (int q = w; q < 64; q += 8) {
        const int p = q >> 4, tm = (q >> 2) & 3, tn = q & 3;
        const f32x4 z4 = {0.f, 0.f, 0.f, 0.f};
        if (p == 0) {
            f32x4 a = mm16(Zt, LS, Bt, LS, tm, tn, 2, lane, z4);
            const int s = 16 * tn + l15, t0 = 16 * tm + 4 * q4;
#pragma unroll
            for (int r = 0; r < 4; ++r) a[r] = (t0 + r > s) ? a[r] : 0.f;
            *(LAS f32x4*)(LT + s * LTS + t0) = a;
            if (tm >= 2 && tn < 2) {
#pragma unroll
                for (int r = 0; r < 4; ++r) L10[(t0 + r - 32) * SS + s] = (bf16)f2bf(a[r]); }
        } else {
            const LAS bf16* A = (p == 2) ? Bt : Kt; const LAS bf16* B = (p == 1) ? Zt : Rt; LAS bf16* W = (p == 1) ? Lzk : (p == 2) ? Lrb : Lrk;
            f32x4 a = mm16(A, LS, B, LS, tm, tn, 2, lane, z4);
            const int t = 16 * tn + l15, s0 = 16 * tm + 4 * q4;
#pragma unroll
            for (int r = 0; r < 4; ++r) { const bool keep = (p == 1) ? (t > s0 + r) : (t >= s0 + r); a[r] = keep ? a[r] : 0.f; }
            wr_nat(W, LS, tm, tn, lane, a);
        }
    }
    }
    WG_BAR();
    {
    LAUNDER_IDX();
    if (w == 0) {
        const int blk = lane >> 5, cc = lane & 31;
        const LAS float* Lb = LT + (32 * blk) * LTS + 32 * blk;
        float x[32];
#pragma unroll
        for (int t = 0; t < 32; ++t) x[t] = (t == cc) ? 1.f : 0.f;
#pragma unroll
        for (int s = 0; s < 31; ++s) {
            const float xs = x[s];
#pragma unroll
            for (int t4 = ((s + 1) >> 2) << 2; t4 < 32; t4 += 4) { const f32x4 lv = *(const LAS f32x4*)(Lb + s * LTS + t4);
#pragma unroll
                for (int r = 0; r < 4; ++r) if (t4 + r > s) x[t4 + r] += lv[r] * xs; }
        }
#pragma unroll
        for (int t = 0; t < 32; ++t) Tl[(32 * blk + t) * LS + 32 * blk + cc] = (bf16)f2bf(x[t]);
#pragma unroll
        for (int g = 0; g < 4; ++g) { v4u o; o.x = pk2(x[8 * g], x[8 * g + 1]); o.y = pk2(x[8 * g + 2], x[8 * g + 3]); o.z = pk2(x[8 * g + 4], x[8 * g + 5]); o.w = pk2(x[8 * g + 6], x[8 * g + 7]);
            *(LAS v4u*)(T00T + lane * SS + 8 * g) = o; }
    } else if (w == 1) {
        const int t = lane >> 1, hf = lane & 1; const v4u z = {0u, 0u, 0u, 0u};
        *(LAS v4u*)(Tl + t * LS + 32 + 16 * hf) = z; *(LAS v4u*)(Tl + t * LS + 32 + 16 * hf + 8) = z;
    } else {
#pragma unroll 1
        for (int q = w - 2; q < 16; q += 6) { const int tm = q >> 2, tn = q & 3; const f32x4 z4 = {0.f, 0.f, 0.f, 0.f};
            wr_nat(X1T, LS, tm, tn, lane, mm16(Lzk, LS, VT, LS, tm, tn, 2, lane, z4)); }
    }
    }
    WG_BAR();
    { LAUNDER_IDX();
    if (w < 4) { const int tm = w >> 1, tn = w & 1; const f32x4 z4 = {0.f, 0.f, 0.f, 0.f};
        wr_nat(XT, SS, tm, tn, lane, mm16(L10, SS, T00T, SS, tm, tn, 1, lane, z4)); } }
    WG_BAR();
    { LAUNDER_IDX();
    if (w < 4) { const int tm = w >> 1, tn = w & 1; const f32x4 z4 = {0.f, 0.f, 0.f, 0.f};
        const f32x4 a = mm16(XT, SS, Tl + 32 * LS + 32, LS, tm, tn, 1, lane, z4);
        *(LAS u32x2*)(Tl + (32 + 16 * tn + l15) * LS + 16 * tm + 4 * q4) = pack4(a); } }
    WG_BAR();
    { LAUNDER_IDX();
#pragma unroll 1
    for (int q = w; q < 32; q += 8) { const int p = q >> 4, tm = (q >> 2) & 3, tn = q & 3; const f32x4 z4 = {0.f, 0.f, 0.f, 0.f};
        if (p == 0) wr_nat(WzT, LS, tm, tn, lane, mm16(Tl, LS, ZtT, LS, tm, tn, 2, lane, z4));
        else wr_nat(U0T, LS, tm, tn, lane, mm16(Tl, LS, X1T, LS, tm, tn, 2, lane, z4)); } }
    WG_BAR();
    { LAUNDER_IDX();
#pragma unroll 1
    for (int q = w; q < 64; q += 8) { const int p = q >> 4, tm = (q >> 2) & 3, tn = q & 3; const f32x4 z4 = {0.f, 0.f, 0.f, 0.f};
        const int n = 16 * tn + l15, m0 = 16 * tm + 4 * q4; f32x4 a; bf16* dst;
        if (p == 0) { a = mm16(WzT, LS, BhT, LS, tm, tn, 2, lane, z4);
            const float pc = PCv[n];
#pragma unroll
            for (int r = 0; r < 4; ++r) if (m0 + r == n) a[r] += pc;
            dst = MTg; }
        else if (p == 1) { a = mm16(BhT, LS, U0T, LS, tm, tn, 2, lane, z4); a = mm16(KhT, LS, VT, LS, tm, tn, 2, lane, a); dst = NTg; }
        else if (p == 2) { a = mm16(WzT, LS, Lrb, LS, tm, tn, 2, lane, z4);
            const u32x2 rv = *(const LAS u32x2*)(Rt + n * LS + m0);
            a[0] += __uint_as_float(rv.x << 16); a[1] += __uint_as_float(rv.x & 0xffff0000u); a[2] += __uint_as_float(rv.y << 16); a[3] += __uint_as_float(rv.y & 0xffff0000u);
            dst = RZg; }
        else { a = mm16(Lrb, LS, U0T, LS, tm, tn, 2, lane, z4); a = mm16(Lrk, LS, VT, LS, tm, tn, 2, lane, a); dst = Y0g; }
        *(GAS u32x2*)(dst + n * 64 + m0) = pack4(a);
    } }
    WG_BAR();
}

__device__ __forceinline__ float row16_sum(float v) {
    v += __builtin_bit_cast(float, __builtin_amdgcn_update_dpp(0, __builtin_bit_cast(int, v), 0xB1, 0xF, 0xF, true));
    v += __builtin_bit_cast(float, __builtin_amdgcn_update_dpp(0, __builtin_bit_cast(int, v), 0x4E, 0xF, 0xF, true));
    v += __builtin_bit_cast(float, __builtin_amdgcn_update_dpp(0, __builtin_bit_cast(int, v), 0x141, 0xF, 0xF, true));
    v += __builtin_bit_cast(float, __builtin_amdgcn_update_dpp(0, __builtin_bit_cast(int, v), 0x140, 0xF, 0xF, true));
    return v;
}
__device__ __forceinline__ f32x4 unpack4(u32x2 v) { f32x4 r; r[0] = __uint_as_float(v.x << 16); r[1] = __uint_as_float(v.x & 0xffff0000u); r[2] = __uint_as_float(v.y << 16); r[3] = __uint_as_float(v.y & 0xffff0000u); return r; }
__device__ __forceinline__ void rwkv_scan(Frame& F, const bf16* P, int bh) {
    const int b = bh >> 3, h = bh & 7, lane = F.lane, w = F.wave, q4 = lane >> 4, l15 = lane & 15;
    LAS bf16* SB0 = (LAS bf16*)(F.lds + RING_OFF); LAS bf16* SB1 = SB0 + 64 * LS;
    unsigned char* ws = (unsigned char*)F.ctl;
    const size_t ubase = (size_t)(b * NH + h) * NCH;
    const bf16* MTg = (const bf16*)(ws + WS_MT) + ubase * 4096; const bf16* NTg = (const bf16*)(ws + WS_NT) + ubase * 4096;
    const bf16* RZg = (const bf16*)(ws + WS_RZ) + ubase * 4096; const bf16* Y0g = (const bf16*)(ws + WS_Y0) + ubase * 4096;
    const bf16* GBg = (const bf16*)(ws + WS_GB); const float* BONg = (const float*)(ws + WS_BON);
    for (int u = F.tid; u < 64 * LS / 2; u += NWAVES * 64) ((LAS unsigned*)SB0)[u] = 0u;
    WG_BAR();
    const bool isY = w < 4; const int tm = w & 3;
    const bf16* Ag = isY ? RZg : MTg; const bf16* Ig = isY ? Y0g : NTg;
    float gnw[4], gnb[4], muv[4];
#pragma unroll
    for (int tn = 0; tn < 4; ++tn) { const int gi = h * 64 + 16 * tn + l15; gnw[tn] = F.in[I_GNW][gi]; gnb[tn] = F.in[I_GNB][gi]; muv[tn] = F.in[I_MU][2 * DRW + gi]; }
#pragma unroll 1
    for (int c = 0; c < NCH; ++c) {
        const LAS bf16* Sc = (c & 1) ? SB1 : SB0; LAS bf16* Sn = (c & 1) ? SB0 : SB1;
        const bf16* Au = Ag + (size_t)c * 4096 + (16 * tm + l15) * 64 + 8 * q4; const bf16* Iu = Ig + (size_t)c * 4096 + 16 * tm + 4 * q4;
        const bf16x8 a0 = *(const GAS bf16x8*)Au, a1 = *(const GAS bf16x8*)(Au + 32);
        f32x4 acc[4];
#pragma unroll
        for (int tn = 0; tn < 4; ++tn) acc[tn] = unpack4(*(const GAS u32x2*)(Iu + (16 * tn + l15) * 64));
#pragma unroll
        for (int tn = 0; tn < 4; ++tn) { const LAS bf16* bp = Sc + (16 * tn + l15) * LS + 8 * q4;
            acc[tn] = mfma16(a0, *(const LAS bf16x8*)bp, acc[tn]); acc[tn] = mfma16(a1, *(const LAS bf16x8*)(bp + 32), acc[tn]); }
        if (!isY) {
#pragma unroll
            for (int tn = 0; tn < 4; ++tn) *(LAS u32x2*)(Sn + (16 * tn + l15) * LS + 16 * tm + 4 * q4) = pack4(acc[tn]);
        } else {
            const size_t tg0 = (size_t)b * SEQ + c * 64 + 16 * tm + 4 * q4;
#pragma unroll
            for (int r = 0; r < 4; ++r) {
                const float s = row16_sum((acc[0][r] + acc[1][r]) + (acc[2][r] + acc[3][r])); const float mean = s * (1.f / 64.f);
                float d[4], qq = 0.f;
#pragma unroll
                for (int tn = 0; tn < 4; ++tn) { d[tn] = acc[tn][r] - mean; qq += d[tn] * d[tn]; }
                const float rstd = 1.0f / sqrtf(row16_sum(qq) * (1.f / 64.f) + GN_EPS);
                const size_t tg = tg0 + r; const float bon = BONg[tg * NH + h];
                const bool hasprev = (c * 64 + 16 * tm + 4 * q4 + r) > 0;
#pragma unroll
                for (int tn = 0; tn < 4; ++tn) { const int gi = h * 64 + 16 * tn + l15;
                    const float vc = bf2f(P[tg * DIN + 2 * DRW + gi]); const float vp = hasprev ? bf2f(P[(tg - 1) * DIN + 2 * DRW + gi]) : 0.f; const float v = vc + (vp - vc) * muv[tn];
                    const float yn = d[tn] * rstd * gnw[tn] + gnb[tn] + bon * v;
                    F.OAB[tg * D + gi] = (bf16)f2bf(yn * bf2f(GBg[tg * DRW + gi])); }
            }
        }
        WG_BAR();
    }
}

struct Args { const float* in[28]; float* out; unsigned char* ws; int ph_lo, ph_hi; };
__global__ void __launch_bounds__(NWAVES * 64, 2) mk_fwd(Args args) {
    extern __shared__ __attribute__((aligned(16))) unsigned char lds[];
    Frame F;
    F.lds = (LAS unsigned char*)lds;
    F.MISC = (volatile LAS unsigned*)(F.lds + MISC_OFF);
    F.tid = threadIdx.x; F.lane = F.tid & 63; F.wave = __builtin_amdgcn_readfirstlane(F.tid >> 6);
    F.G = gridDim.x; { const int bx = blockIdx.x; F.vcu = (F.G % 8 == 0) ? (bx % 8) * (F.G / 8) + bx / 8 : bx; }
    unsigned char* ws = args.ws;
    F.ctl = (gu32*)(ws + WS_CTL); F.ws = ws;
#pragma unroll
    for (int i = 0; i < 28; ++i) F.in[i] = args.in[i];
    F.out = args.out;
    F.Wgu1 = (bf16*)(ws + WS_WGU1); F.Wdn1 = (bf16*)(ws + WS_WDN1); F.Win = (bf16*)(ws + WS_WIN); F.Wout = (bf16*)(ws + WS_WOUT); F.Wgu2 = (bf16*)(ws + WS_WGU2); F.Wdn2 = (bf16*)(ws + WS_WDN2);
    F.XN = (bf16*)(ws + WS_XN); F.H = (bf16*)(ws + WS_H); F.OAB = (bf16*)(ws + WS_OAB); F.Fm = (float*)(ws + WS_F);
    for (int u = F.tid; u < (LDS_BYTES - LDSCTL_OFF) / 4; u += NWAVES * 64) ((LAS unsigned*)(F.lds + LDSCTL_OFF))[u] = 0u;
    __syncthreads();
    XcdBarrier bar; bar.bar = (unsigned*)(F.ctl + CW_BAR); bar.x = 0; bar.st = nullptr;
    if (MK_ONE_LAUNCH) bar = xcd_barrier_post((unsigned*)(F.ctl + CW_BAR), F.MISC + 8);
    const int lo = args.ph_lo, hi = args.ph_hi;
#ifndef PH_MASK
#define PH_MASK 0xFFFF
#endif
#define IN(k) (((PH_MASK >> (k)) & 1) && lo <= (k) && (k) < hi)
#define SEAM(k) do { if (IN(k) && IN((k) + 1)) xcd_barrier(bar); } while (0)

    if (IN(0)) { p0_prologue(F); } SEAM(0);
    if (IN(1)) { pg8::Gemm g{F.XN, F.Wgu1, M, NGU, D}; pg8::StaticOrder S; S.init(M, NGU, F.G, (int)blockIdx.x); pg8::EpiSwiGLU E{F.H, DFF};
        pg8::gemm_phase<pg8::EpiSwiGLU, pg8::StaticOrder, true, true>(F.lds + RING_OFF, g, S, E); } SEAM(1);
    if (IN(2)) { pg8::Gemm g{F.H, F.Wdn1, M, D, DFF}; pg8::StaticOrder S; S.init(M, D, F.G, (int)blockIdx.x); pg8::EpiF32 E{F.Fm, D};
        pg8::gemm_phase<pg8::EpiF32, pg8::StaticOrder, true, true>(F.lds + RING_OFF, g, S, E); } SEAM(2);
    if (IN(3)) { norm_pass(F, F.Fm, F.in[I_X], F.out, F.in[I_F1POST], 0.5f, F.in[I_MPRE], F.XN); } SEAM(3);
    if (IN(4)) { pg8::Gemm g{F.XN, F.Win, M, DIN, D}; pg8::StaticOrder S; S.init(M, DIN, F.G, (int)blockIdx.x); pg8::EpiBf16 E{F.H, DIN};
        pg8::gemm_phase<pg8::EpiBf16, pg8::StaticOrder, true, true>(F.lds + RING_OFF, g, S, E); } SEAM(4);
    if (IN(5)) { for (int pu = F.vcu; pu < BATCH * NCH; pu += F.G) for (int h = 0; h < NH; ++h) rwkv_prep_unit(F, F.H, pu / NCH, pu % NCH, h); } SEAM(5);
    if (IN(6)) {
        if ((int)blockIdx.x < BATCH * NH) rwkv_scan(F, F.H, (int)blockIdx.x);
        else for (int u = (int)blockIdx.x - BATCH * NH; u < M / 32; u += F.G - BATCH * NH) conv_unit(F, F.H, u);
    } SEAM(6);
    if (IN(7)) { pg8::Gemm g{F.OAB, F.Wout, M, D, D}; pg8::StaticOrder S; S.init(M, D, F.G, (int)blockIdx.x); pg8::EpiF32 E{F.Fm, D};
        pg8::gemm_phase<pg8::EpiF32, pg8::StaticOrder, true, true>(F.lds + RING_OFF, g, S, E); } SEAM(7);
    if (IN(8)) { norm_pass(F, F.Fm, F.out, F.out, F.in[I_MPOST], 1.0f, F.in[I_F2PRE], F.XN); } SEAM(8);
    if (IN(9)) { pg8::Gemm g{F.XN, F.Wgu2, M, NGU, D}; pg8::StaticOrder S; S.init(M, NGU, F.G, (int)blockIdx.x); pg8::EpiSwiGLU E{F.H, DFF};
        pg8::gemm_phase<pg8::EpiSwiGLU, pg8::StaticOrder, true, true>(F.lds + RING_OFF, g, S, E); } SEAM(9);
    if (IN(10)) { pg8::Gemm g{F.H, F.Wdn2, M, D, DFF}; pg8::StaticOrder S; S.init(M, D, F.G, (int)blockIdx.x); pg8::EpiF32 E{F.Fm, D};
        pg8::gemm_phase<pg8::EpiF32, pg8::StaticOrder, true, true>(F.lds + RING_OFF, g, S, E); } SEAM(10);
    if (IN(11)) { norm_pass(F, F.Fm, F.out, F.out, F.in[I_F2POST], 0.5f, nullptr, nullptr); }
#undef IN
#undef SEAM
}

extern "C" void kernel_launch(void* const* d_in, const int* in_sizes, int n_in, void* d_out, int out_size, void* d_ws, size_t ws_size, hipStream_t stream) {
    static int grid = 0;
    if (grid == 0) {
        if (n_in != 28 || in_sizes[0] != M * D || out_size != M * D || ws_size < WS_END) { fprintf(stderr, "kernel_launch: unexpected shapes (n_in %d, in0 %d, out %d, ws %zu); nothing launched\n", n_in, n_in > 0 ? in_sizes[0] : -1, out_size, ws_size); grid = -1; return; }
        int dev = 0, cus = 0, per_cu = 0;
        if (hipGetDevice(&dev) != hipSuccess || hipDeviceGetAttribute(&cus, hipDeviceAttributeMultiprocessorCount, dev) != hipSuccess) { grid = -1; return; }
        if (hipFuncSetAttribute((const void*)mk_fwd, hipFuncAttributeMaxDynamicSharedMemorySize, LDS_BYTES) != hipSuccess) { fprintf(stderr, "kernel_launch: hipFuncSetAttribute failed\n"); grid = -1; return; }
        if (hipOccupancyMaxActiveBlocksPerMultiprocessor(&per_cu, (const void*)mk_fwd, NWAVES * 64, LDS_BYTES) != hipSuccess || per_cu < 1) { fprintf(stderr, "kernel_launch: occupancy query says %d blocks per CU; nothing launched\n", per_cu); (void)hipGetLastError(); grid = -1; return; }
        grid = cus;
    }
    if (grid < 0) return;
    if (hipMemsetAsync((char*)d_ws + WS_CTL, 0, CTL_ZERO_BYTES, stream) != hipSuccess) { fprintf(stderr, "kernel_launch: hipMemsetAsync failed\n"); return; }
    Args a{};
    for (int i = 0; i < 28; ++i) a.in[i] = (const float*)d_in[i];
    a.out = (float*)d_out; a.ws = (unsigned char*)d_ws;
#if MK_ONE_LAUNCH
    a.ph_lo = 0; a.ph_hi = N_PHASES;
    hipLaunchKernelGGL(mk_fwd, dim3(grid), dim3(NWAVES * 64), LDS_BYTES, stream, a);
#else
    for (int p = 0; p < N_PHASES; ++p) { a.ph_lo = p; a.ph_hi = p + 1; hipLaunchKernelGGL(mk_fwd, dim3(grid), dim3(NWAVES * 64), LDS_BYTES, stream, a); }
#endif
    const hipError_t le = hipPeekAtLastError();
    if (le != hipSuccess) fprintf(stderr, "kernel_launch: launch failed: %s\n", hipGetErrorName(le));
}
```

```cpp
#include <hip/hip_runtime.h>
#include <cstdio>
#include <cstdint>
namespace pg8 {
#define PG8_LAS __attribute__((address_space(3)))
typedef unsigned short bf16_t;
typedef short bf16x8 __attribute__((ext_vector_type(8)));
typedef float f32x4 __attribute__((ext_vector_type(4)));
typedef unsigned u32x4 __attribute__((ext_vector_type(4)));
constexpr int BM = 256, BK = 64, HALF = 128, HTB = HALF * BK * 2  , STAGE_BYTES = 8 * HTB, NXCD = 8, WGM = 8;

__host__ __device__ __forceinline__ int lds_byte(int r, int c) { const int st = (r >> 4) * 2 + (c >> 5), rr = r & 15, cc = c & 31, ob = rr * 64 + cc * 2; return st * 1024 + (ob ^ (((ob >> 9) & 1) << 5)); }
__host__ __device__ __forceinline__ void stage_rc(int b, int& R, int& C) { const int st = b / 1024, sb = b % 1024, swz = sb ^ (((sb >> 9) & 1) << 5); R = (st >> 1) * 16 + swz / 64; C = (st & 1) * 32 + (swz % 64) / 2; }
__host__ __device__ __forceinline__ int perm32(int rho) { const int n = rho >> 4, i = rho & 15; return 8 * (i >> 2) + 4 * n + (i & 3); }

struct Unit { int pm, pn; };
struct Gemm { const bf16_t* A; const bf16_t* Bt; int M, N, K; };

struct StaticOrder {
    int nM, nN, nwg, G, c;
    __host__ __device__ void init(int M, int N, int G_, int c_) { nM = M / BM; nN = N / BM; nwg = nM * nN; G = G_; c = c_; }
    __host__ __device__ bool next(int i, Unit& u) const {
        const long L = (long)i * G + c; if (L >= nwg) return false;
        int wgid = (int)L; { const int q = nwg / NXCD, r = nwg % NXCD, xcd = wgid % NXCD, off = wgid / NXCD; wgid = (xcd < r ? xcd * (q + 1) : r * (q + 1) + (xcd - r) * q) + off; }
        const int nig = WGM * nN, gid = wgid / nig, fm = gid * WGM, gsz = (nM - fm) < WGM ? (nM - fm) : WGM;
        u.pm = fm + ((wgid % nig) % gsz); u.pn = (wgid % nig) / gsz; return true;
    }
    __device__ __forceinline__ void a_ready(const Unit&) const {}
    __device__ __forceinline__ void done(const Unit&) const {}
};
__device__ __forceinline__ unsigned cvt_pk_bf16(float lo, float hi) { unsigned r; asm volatile("v_cvt_pk_bf16_f32 %0, %1, %2" : "=v"(r) : "v"(lo), "v"(hi)); return r; }
typedef float f32x2 __attribute__((ext_vector_type(2)));
__device__ __forceinline__ float silu_mul(float g, float u) { const float e = __builtin_amdgcn_exp2f(g * -1.44269504f); return g * __builtin_amdgcn_rcpf(1.0f + e) * u; }

struct EpiBf16 {
    static constexpr bool PERM = true, AFTER_DRAIN = false;
    bf16_t* O; int ldc;
    __device__ __forceinline__ void operator()(const f32x4 (&acc)[2][2][4][2], const Unit& u, int wr, int wc, int fr, int fq) const {
        const int row0 = u.pm * BM + wr * 64 + fr; const int col0 = u.pn * BM + wc * 32 + 8 * fq;
#pragma unroll
        for (int ai = 0; ai < 2; ++ai)
#pragma unroll
            for (int m = 0; m < 4; ++m) { bf16_t* rowp = O + (size_t)(row0 + ai * HALF + m * 16) * ldc + col0;
#pragma unroll
                for (int bj = 0; bj < 2; ++bj) { const f32x4 v0 = acc[ai][bj][m][0], v1 = acc[ai][bj][m][1];
                    u32x4 w; w.x = cvt_pk_bf16(v0[0], v0[1]); w.y = cvt_pk_bf16(v0[2], v0[3]); w.z = cvt_pk_bf16(v1[0], v1[1]); w.w = cvt_pk_bf16(v1[2], v1[3]);
                    *(u32x4*)(rowp + bj * HALF) = w; } }
    }
};
struct EpiSwiGLU {
    static constexpr bool PERM = true, AFTER_DRAIN = false;
    bf16_t* H; int ldh;
    __device__ __forceinline__ void operator()(const f32x4 (&acc)[2][2][4][2], const Unit& u, int wr, int wc, int fr, int fq) const {
        const int row0 = u.pm * BM + wr * 64 + fr; const int col0 = u.pn * HALF + wc * 32 + 8 * fq;
#pragma unroll
        for (int ai = 0; ai < 2; ++ai)
#pragma unroll
            for (int m = 0; m < 4; ++m) { bf16_t* rowp = H + (size_t)(row0 + ai * HALF + m * 16) * ldh + col0;
                const f32x4 g0 = acc[ai][0][m][0], g1 = acc[ai][0][m][1], u0 = acc[ai][1][m][0], u1 = acc[ai][1][m][1];
                u32x4 w; w.x = cvt_pk_bf16(silu_mul(g0[0], u0[0]), silu_mul(g0[1], u0[1])); w.y = cvt_pk_bf16(silu_mul(g0[2], u0[2]), silu_mul(g0[3], u0[3]));
                w.z = cvt_pk_bf16(silu_mul(g1[0], u1[0]), silu_mul(g1[1], u1[1])); w.w = cvt_pk_bf16(silu_mul(g1[2], u1[2]), silu_mul(g1[3], u1[3]));
                *(u32x4*)rowp = w; }
    }
};
struct EpiF32 {
    static constexpr bool PERM = false, AFTER_DRAIN = false;
    float* C; int ldc;
    __device__ __forceinline__ void operator()(const f32x4 (&acc)[2][2][4][2], const Unit& u, int wr, int wc, int fr, int fq) const {
        const int row0 = u.pm * BM + wr * 64 + fr, col0 = u.pn * BM + wc * 32 + 4 * fq;
#pragma unroll
        for (int ai = 0; ai < 2; ++ai)
#pragma unroll
            for (int m = 0; m < 4; ++m) { float* rowp = C + (size_t)(row0 + ai * HALF + m * 16) * ldc + col0;
#pragma unroll
                for (int bj = 0; bj < 2; ++bj)
#pragma unroll
                    for (int n = 0; n < 2; ++n) *(f32x4*)(rowp + bj * HALF + n * 16) = acc[ai][bj][m][n]; }
    }
};
template <class Epi, class Sched, bool ALIGN_EPI = false, bool SP2 = false>
__device__ __forceinline__ void gemm_phase(PG8_LAS unsigned char* lds, const Gemm g, const Sched& S, const Epi& E) {
    const int tid = threadIdx.x, wid = __builtin_amdgcn_readfirstlane(tid >> 6), lane = tid & 63, wr = wid >> 2, wc = wid & 3, fr = lane & 15, fq = lane >> 4;
    const int K = g.K, nt = K / BK;
    unsigned voffA[2], voffB[2];
#pragma unroll
    for (int i = 0; i < 2; ++i) { int R, C; stage_rc(tid * 16 + i * 8192, R, C); const int Rb = Epi::PERM ? ((R & ~31) + perm32(R & 31)) : R;
        voffA[i] = (unsigned)(R * K + C) * 2u; voffB[i] = (unsigned)(Rb * K + C) * 2u; }
    const size_t kstep = (size_t)(BK * 2);
    const size_t hstep = (size_t)HALF * K * 2;
    const size_t tstep = 2 * hstep;
    const unsigned ldsw = (unsigned)wid * 1024u;
    const int aoff = lds_byte(wr * 64 + fr, fq * 8), boff = lds_byte(wc * 32 + fr, fq * 8);
#define PG8_SA(b, h) (((b) * 2 + (h)) * HTB)
#define PG8_SB(b, h) ((4 + (b) * 2 + (h)) * HTB)
#define PG8_STAGE(bufoff, gbase, voff) do { _Pragma("unroll") for (int _i = 0; _i < 2; ++_i) \
        __builtin_amdgcn_global_load_lds((const unsigned*)((const char*)(gbase) + (voff)[_i]), (PG8_LAS unsigned*)(lds + (bufoff) + ldsw + _i * 8192), 16, 0, 0); } while (0)
#define PG8_LDA(dst, b, h) do { _Pragma("unroll") for (int m = 0; m < 4; ++m) _Pragma("unroll") for (int k = 0; k < 2; ++k) dst[m][k] = *(const PG8_LAS bf16x8*)(lds + PG8_SA(b, h) + aoff + m * 2048 + k * 1024); } while (0)
#define PG8_LDB(dst, b, h) do { _Pragma("unroll") for (int n = 0; n < 2; ++n) _Pragma("unroll") for (int k = 0; k < 2; ++k) dst[n][k] = *(const PG8_LAS bf16x8*)(lds + PG8_SB(b, h) + boff + n * 2048 + k * 1024); } while (0)
#define PG8_MMA(ai, bj, At, Bt) do { __builtin_amdgcn_s_setprio(1); _Pragma("unroll") for (int m = 0; m < 4; ++m) _Pragma("unroll") for (int n = 0; n < 2; ++n) _Pragma("unroll") for (int k = 0; k < 2; ++k) \
        acc[ai][bj][m][n] = __builtin_amdgcn_mfma_f32_16x16x32_bf16(Bt[n][k], At[m][k], acc[ai][bj][m][n], 0, 0, 0); __builtin_amdgcn_s_setprio(0); } while (0)
#define PG8_WAIT_V(n) asm volatile("s_waitcnt vmcnt(" #n ")" ::: "memory")
#define PG8_WAIT_L(n) asm volatile("s_waitcnt lgkmcnt(" #n ")" ::: "memory")
#define PG8_BAR __builtin_amdgcn_s_barrier()
#define PG8_SCHED __builtin_amdgcn_sched_barrier(0)
    Unit cur, nxt; int ui = 0;
    if (!S.next(0, cur)) return;
    f32x4 acc[2][2][4][2];
#pragma unroll
    for (int a = 0; a < 2; ++a)
#pragma unroll
        for (int b = 0; b < 2; ++b)
#pragma unroll
            for (int m = 0; m < 4; ++m)
#pragma unroll
                for (int n = 0; n < 2; ++n) acc[a][b][m][n] = (f32x4){0.f, 0.f, 0.f, 0.f};
    bf16x8 At[4][2], B0[2][2], B1[2][2];
    const char* cA = (const char*)g.A + (size_t)cur.pm * tstep; const char* cB = (const char*)g.Bt + (size_t)cur.pn * tstep;
    S.a_ready(cur);
    if constexpr (SP2) {
        PG8_STAGE(PG8_SB(0, 0), cB, voffB); PG8_STAGE(PG8_SB(0, 1), cB + hstep, voffB); PG8_STAGE(PG8_SA(0, 0), cA, voffA); PG8_STAGE(PG8_SA(0, 1), cA + hstep, voffA);
        if (wr == 1) PG8_BAR;
        PG8_WAIT_V(2); PG8_BAR;
        PG8_STAGE(PG8_SB(1, 0), cB + kstep, voffB); PG8_STAGE(PG8_SA(1, 0), cA + kstep, voffA); PG8_STAGE(PG8_SB(1, 1), cB + hstep + kstep, voffB);
        PG8_WAIT_V(6); PG8_BAR;
    } else {
        PG8_STAGE(PG8_SB(0, 0), cB, voffB); PG8_STAGE(PG8_SA(0, 0), cA, voffA); PG8_STAGE(PG8_SB(0, 1), cB + hstep, voffB); PG8_STAGE(PG8_SA(0, 1), cA + hstep, voffA);
        if (wr == 1) PG8_BAR;
        PG8_WAIT_V(4); PG8_BAR;
        PG8_STAGE(PG8_SB(1, 0), cB + kstep, voffB); PG8_STAGE(PG8_SA(1, 0), cA + kstep, voffA); PG8_STAGE(PG8_SB(1, 1), cB + hstep + kstep, voffB);
        PG8_WAIT_V(6); PG8_BAR;
    }
    for (;;) {
        const bool has_next = S.next(ui + 1, nxt);
        const char* nA = has_next ? (const char*)g.A + (size_t)nxt.pm * tstep : cA; const char* nB = has_next ? (const char*)g.Bt + (size_t)nxt.pn * tstep : cB;
        for (int t = 0; t < nt; t += 2) {
            const bool last = (t == nt - 2);
            const char* a1 = cA + (size_t)(t + 1) * kstep;
            const char* a2 = last ? nA : cA + (size_t)(t + 2) * kstep; const char* b2 = last ? nB : cB + (size_t)(t + 2) * kstep;
            const char* a3 = a2 + kstep; const char* b3 = b2 + kstep;
            if (last && has_next) S.a_ready(nxt);
            if constexpr (SP2) {
            PG8_LDB(B0, 0, 0); PG8_LDB(B1, 0, 1); PG8_SCHED; PG8_LDA(At, 0, 0); PG8_STAGE(PG8_SA(1, 1), a1 + hstep, voffA);
            PG8_WAIT_V(8); PG8_WAIT_L(0); PG8_BAR; PG8_MMA(0, 0, At, B0); PG8_MMA(0, 1, At, B1); PG8_BAR; PG8_SCHED;
            PG8_LDA(At, 0, 1); PG8_STAGE(PG8_SB(0, 0), b2, voffB); PG8_STAGE(PG8_SB(0, 1), b2 + hstep, voffB); PG8_STAGE(PG8_SA(0, 0), a2, voffA);
            PG8_WAIT_V(8); PG8_WAIT_L(0); PG8_BAR; PG8_MMA(1, 0, At, B0); PG8_MMA(1, 1, At, B1); PG8_BAR; PG8_SCHED;
            PG8_LDB(B0, 1, 0); PG8_LDB(B1, 1, 1); PG8_SCHED; PG8_LDA(At, 1, 0); PG8_STAGE(PG8_SA(0, 1), a2 + hstep, voffA);
            PG8_WAIT_V(8); PG8_WAIT_L(0); PG8_BAR; PG8_MMA(0, 0, At, B0); PG8_MMA(0, 1, At, B1); PG8_BAR; PG8_SCHED;
            PG8_LDA(At, 1, 1); PG8_STAGE(PG8_SB(1, 0), b3, voffB); PG8_STAGE(PG8_SB(1, 1), b3 + hstep, voffB); PG8_STAGE(PG8_SA(1, 0), a3, voffA);
            PG8_WAIT_V(8); PG8_WAIT_L(0); PG8_BAR; PG8_MMA(1, 0, At, B0); PG8_MMA(1, 1, At, B1); PG8_BAR; PG8_SCHED;
            } else {
            PG8_LDB(B0, 0, 0); PG8_SCHED; PG8_LDA(At, 0, 0); PG8_STAGE(PG8_SA(1, 1), a1 + hstep, voffA);
            PG8_WAIT_L(8); PG8_BAR; PG8_WAIT_L(0); PG8_MMA(0, 0, At, B0); PG8_BAR; PG8_SCHED;
            PG8_LDB(B1, 0, 1); PG8_STAGE(PG8_SB(0, 0), b2, voffB);
            PG8_BAR; PG8_WAIT_L(0); PG8_MMA(0, 1, At, B1); PG8_BAR;
            PG8_LDA(At, 0, 1); PG8_STAGE(PG8_SA(0, 0), a2, voffA);
            PG8_BAR; PG8_WAIT_L(0); PG8_MMA(1, 0, At, B0); PG8_BAR; PG8_SCHED;
            PG8_STAGE(PG8_SB(0, 1), b2 + hstep, voffB);
            PG8_WAIT_V(6); PG8_BAR; PG8_MMA(1, 1, At, B1); PG8_BAR;
            PG8_LDB(B0, 1, 0); PG8_SCHED; PG8_LDA(At, 1, 0); PG8_STAGE(PG8_SA(0, 1), a2 + hstep, voffA);
            PG8_WAIT_L(8); PG8_BAR; PG8_WAIT_L(0); PG8_MMA(0, 0, At, B0); PG8_BAR; PG8_SCHED;
            PG8_LDB(B1, 1, 1); PG8_STAGE(PG8_SB(1, 0), b3, voffB);
            PG8_BAR; PG8_WAIT_L(0); PG8_MMA(0, 1, At, B1); PG8_BAR;
            PG8_LDA(At, 1, 1); PG8_STAGE(PG8_SA(1, 0), a3, voffA);
            PG8_BAR; PG8_WAIT_L(0); PG8_MMA(1, 0, At, B0); PG8_BAR; PG8_SCHED;
            PG8_STAGE(PG8_SB(1, 1), b3 + hstep, voffB);
            PG8_WAIT_V(6); PG8_BAR; PG8_MMA(1, 1, At, B1); PG8_BAR;
            }
        }
        if constexpr (ALIGN_EPI) { if (wr == 0) PG8_BAR; }
        if constexpr (!Epi::AFTER_DRAIN) { E(acc, cur, wr, wc, fr, fq); S.done(cur); }
        if (!has_next) break;
#pragma unroll
        for (int a = 0; a < 2; ++a)
#pragma unroll
            for (int b = 0; b < 2; ++b)
#pragma unroll
                for (int m = 0; m < 4; ++m)
#pragma unroll
                    for (int n = 0; n < 2; ++n) acc[a][b][m][n] = (f32x4){0.f, 0.f, 0.f, 0.f};
        cur = nxt; cA = nA; cB = nB; ++ui;
        if constexpr (ALIGN_EPI) { if (wr == 1) PG8_BAR; }
    }
    PG8_WAIT_V(0);
    if constexpr (!ALIGN_EPI) { if (wr == 0) PG8_BAR; }
    PG8_BAR;
    if constexpr (Epi::AFTER_DRAIN) { E.fused(acc, cur, wr, wc, fr, fq, lds, wid, lane); S.done(cur); }
#undef PG8_SA
#undef PG8_SB
#undef PG8_STAGE
#undef PG8_LDA
#undef PG8_LDB
#undef PG8_MMA
#undef PG8_WAIT_V
#undef PG8_WAIT_L
#undef PG8_BAR
#undef PG8_SCHED
}
}
constexpr int NWAVES = 8;
constexpr int BATCH = 8, SEQ = 4096, D = 1024, M = BATCH * SEQ;
constexpr int DFF = 2816, NGU = 2 * DFF, DRW = 512, DCV = 512, NH = 8, HS = 64;
constexpr int DSHIFT = 3 * DRW + 64 + 64 + 128;
constexpr int DIN = DSHIFT + 2 * DCV;
constexpr int CONVW = 31;
constexpr float RMS_EPS = 1e-6f, GN_EPS = 64e-5f, LN_EPS = 1e-5f, DECAY_SCALE = 0.60653065971f;
#ifndef MK_ONE_LAUNCH
#define MK_ONE_LAUNCH 1
#endif
constexpr int N_PHASES = 12;

constexpr size_t MiB = 1u << 20;
constexpr size_t WS_CTL = 0, CTL_ZERO_BYTES = 1 * MiB;
constexpr size_t WS_WGU1 = 2 * MiB, WS_WDN1 = 13 * MiB, WS_WIN = 19 * MiB, WS_WOUT = 25 * MiB, WS_WGU2 = 27 * MiB, WS_WDN2 = 38 * MiB;
constexpr size_t WS_XN = 48 * MiB;
constexpr size_t WS_H = 112 * MiB;
constexpr size_t WS_F = 288 * MiB;
constexpr size_t WS_OAB = 416 * MiB;
constexpr size_t WS_END = 480 * MiB;
static_assert(WS_WGU1 + (size_t)NGU * D * 2 <= WS_WDN1 && WS_WDN1 + (size_t)D * DFF * 2 <= WS_WIN && WS_WIN + (size_t)DIN * D * 2 <= WS_WOUT && WS_WOUT + (size_t)D * D * 2 <= WS_WGU2 &&
              WS_WGU2 + (size_t)NGU * D * 2 <= WS_WDN2 && WS_WDN2 + (size_t)D * DFF * 2 <= WS_XN && WS_XN + (size_t)M * D * 2 <= WS_H && WS_H + (size_t)M * DFF * 2 <= WS_F &&
              WS_F + (size_t)M * D * 4 <= WS_OAB && WS_OAB + (size_t)M * D * 2 <= WS_END, "d_ws map");
constexpr size_t WS_LORA = 44 * MiB;
constexpr size_t WS_MT = WS_XN, WS_NT = WS_XN + 32 * MiB, WS_RZ = WS_F, WS_Y0 = WS_F + 32 * MiB, WS_ET = WS_F + 64 * MiB, WS_GW = WS_F + 96 * MiB;
constexpr int NCH = SEQ / 64;
constexpr int CW_TMO = 0, CW_CODE = 1;
constexpr int CW_BAR = 4096;

constexpr int RING_OFF = 0, RING_BYTES = 147456;
constexpr int LDSCTL_OFF = RING_BYTES, MISC_OFF = LDSCTL_OFF + 320;
constexpr int LDS_BYTES = 148480;
static_assert(MISC_OFF + 128 <= LDS_BYTES, "LDS map");
#define GAS __attribute__((address_space(1)))
#define LAS __attribute__((address_space(3)))
typedef unsigned short bf16;
typedef unsigned v4u __attribute__((ext_vector_type(4)));
typedef float f32x4 __attribute__((ext_vector_type(4)));
typedef short bf16x8 __attribute__((ext_vector_type(8)));
typedef GAS unsigned gu32;
typedef GAS unsigned long long gu64;
#define RLX_AGENT __ATOMIC_RELAXED, __HIP_MEMORY_SCOPE_AGENT
#define LDS_WAIT() asm volatile("s_waitcnt lgkmcnt(0)" ::: "memory")
#define VM_WAIT() asm volatile("s_waitcnt vmcnt(0)" ::: "memory")
__device__ __forceinline__ unsigned long long rt() { return __builtin_amdgcn_s_memrealtime(); }
__device__ __forceinline__ unsigned f2bf(float f) { unsigned u = __builtin_bit_cast(unsigned, f); return (u + 0x7fffu + ((u >> 16) & 1u)) >> 16; }
__device__ __forceinline__ unsigned pk2(float lo, float hi) { return f2bf(lo) | (f2bf(hi) << 16); }
#define XB_TMO      128
#define XB_XCNT(j)  (256  + 64 * (j))
#define XB_XSUB(j)  (1280 + 64 * (j))
#define XB_XGEN(j)  (2304 + 64 * (j))
#define XB_TOP      3328
#define XB_TOPGEN   3392
#define XCD_BAR_WORDS 3456
#define XB_SPIN_CAP (1u << 18)

__device__ __forceinline__ unsigned xb_ld(unsigned* p)              { return __hip_atomic_load(p, __ATOMIC_RELAXED, __HIP_MEMORY_SCOPE_AGENT); }
__device__ __forceinline__ unsigned xb_add(unsigned* p, unsigned v) { return __hip_atomic_fetch_add(p, v, __ATOMIC_RELAXED, __HIP_MEMORY_SCOPE_AGENT); }
__device__ __forceinline__ unsigned xb_xcc_id() { return (unsigned)__builtin_amdgcn_s_getreg((3 << 11) | 20) & 0xFu; }
#define XB_SPIN(cond, bar) do { unsigned _sp = 0; while (cond) { __builtin_amdgcn_s_sleep(1); \
    if ((++_sp & 255u) == 0u) { if (xb_ld(&(bar)[XB_TMO])) break; if (_sp > XB_SPIN_CAP) { atomicAdd(&(bar)[XB_TMO], 1u); break; } } } } while (0)

struct XcdBarrier {
    unsigned* bar; unsigned x;
    volatile LAS unsigned* st;
};

__device__ __forceinline__ XcdBarrier xcd_barrier_post(unsigned* bar, volatile LAS unsigned* st) {
    XcdBarrier b; b.bar = bar; b.x = xb_xcc_id(); b.st = st;
    if (threadIdx.x == 0) (void)xb_add(&bar[XB_XCNT(b.x)], 1u);
    return b;
}
__device__ __forceinline__ void xcd_barrier_complete(unsigned* bar, unsigned x, unsigned& nloc, unsigned& nx) {
    const unsigned G = gridDim.x * gridDim.y * gridDim.z;
    unsigned sum, cnt, mine, sp = 0u;
    for (;;) {
        sum = 0u; cnt = 0u; mine = 0u;
#pragma unroll
        for (unsigned j = 0; j < 16; ++j) { const unsigned c = xb_ld(&bar[XB_XCNT(j)]); sum += c; cnt += (c > 0u) ? 1u : 0u; mine = (j == x) ? c : mine; }
        if (sum == G) break;
        __builtin_amdgcn_s_sleep(1);
        if ((++sp & 255u) == 0u) { if (xb_ld(&bar[XB_TMO])) break; if (sp > XB_SPIN_CAP) { atomicAdd(&bar[XB_TMO], 1u); break; } }
    }
    nloc = mine > 0u ? mine : 1u; nx = cnt > 0u ? cnt : 1u;
}

__device__ __forceinline__ void xcd_barrier(const XcdBarrier& b) {
    asm volatile("s_waitcnt vmcnt(0)" ::: "memory");
    __syncthreads();
    if (threadIdx.x == 0) {
        unsigned* bar = b.bar;
        __builtin_amdgcn_s_waitcnt(0);
        unsigned nloc = b.st[0], nx = b.st[1];
        if (nloc == 0u) { xcd_barrier_complete(bar, b.x, nloc, nx); b.st[0] = nloc; b.st[1] = nx; }
        const unsigned old = xb_add(&bar[XB_XSUB(b.x)], 1u);
        const unsigned gen = old / nloc;
        if (old + 1u == (gen + 1u) * nloc) {
            __builtin_amdgcn_fence(__ATOMIC_RELEASE, "agent");
            asm volatile("s_waitcnt vmcnt(0)" ::: "memory");
            const unsigned og = xb_add(&bar[XB_TOP], 1u);
            const unsigned tg = og / nx;
            if (og + 1u == (tg + 1u) * nx) xb_add(&bar[XB_TOPGEN], 1u);
            else XB_SPIN(xb_ld(&bar[XB_TOPGEN]) == tg, bar);
            __builtin_amdgcn_fence(__ATOMIC_ACQUIRE, "agent");
            xb_add(&bar[XB_XGEN(b.x)], 1u);
            asm volatile("s_waitcnt vmcnt(0)" ::: "memory");
        } else {
            XB_SPIN(xb_ld(&bar[XB_XGEN(b.x)]) == gen, bar);
            __builtin_amdgcn_fence(__ATOMIC_ACQUIRE, "agent");
            asm volatile("s_waitcnt vmcnt(0)" ::: "memory");
        }
    }
    __syncthreads();
}
struct Frame {
    LAS unsigned char* lds;
    volatile LAS unsigned* MISC;
    gu32* ctl; unsigned char* ws;
    int tid, lane, wave;
    int vcu, G;
    const float* in[28]; float* out;
    bf16 *Wgu1, *Wdn1, *Win, *Wout, *Wgu2, *Wdn2;
    bf16 *XN, *H, *OAB; float* Fm;
};
enum { I_X = 0, I_F1PRE, I_F1POST, I_F1GU, I_F1DN, I_MPRE, I_MPOST, I_WIN, I_MU, I_WUP, I_W0, I_AUP, I_A0, I_GUP, I_KK, I_KA, I_RK, I_GNW, I_GNB, I_CDW, I_CB, I_CLW, I_CLB, I_WOUT, I_F2PRE, I_F2POST, I_F2GU, I_F2DN };

__device__ __forceinline__ float wave_sum(float v) {
#pragma unroll
    for (int o = 1; o < 64; o <<= 1) v += __shfl_xor(v, o);
    return v;
}
__device__ __forceinline__ float bf2f(bf16 v) { return __uint_as_float(((unsigned)v) << 16); }
__device__ __forceinline__ float sigm(float x) { return 1.0f / (1.0f + __expf(-x)); }

__device__ __forceinline__ void p0_transpose_item(const float* W, int K, int N, bf16* WT, int gu, LAS float* scr, int item, int lane) {
    const int nblk = N / 32, kb = item / nblk, nb = item % nblk, k0 = 64 * kb, n0 = 32 * nb;
    int r0 = n0;
    if (gu) { const int up = n0 >= DFF ? 1 : 0, nn = n0 - up * DFF; r0 = (nn >> 7) * 256 + up * 128 + (nn & 127); }
#pragma unroll 8
    for (int i = 0; i < 32; ++i) { const int kk = 2 * i + (lane >> 5); scr[kk * 33 + (lane & 31)] = W[(size_t)(k0 + kk) * N + n0 + (lane & 31)]; }
    LDS_WAIT(); asm volatile("" ::: "memory");
    const int c = lane & 7;
#pragma unroll
    for (int j = 0; j < 4; ++j) { const int n = (lane >> 3) + 8 * j; const LAS float* s = scr + (8 * c) * 33 + n;
        v4u o; o.x = pk2(s[0 * 33], s[1 * 33]); o.y = pk2(s[2 * 33], s[3 * 33]); o.z = pk2(s[4 * 33], s[5 * 33]); o.w = pk2(s[6 * 33], s[7 * 33]);
        *(GAS v4u*)(WT + (size_t)(r0 + n) * K + k0 + 8 * c) = o; }
    LDS_WAIT(); asm volatile("" ::: "memory");
}
__device__ __forceinline__ void rms_row_to_bf16(Frame& F, const float* xrow, const float* g, bf16* orow) {
    const GAS f32x4* xr = (const GAS f32x4*)xrow + F.lane; const GAS f32x4* gr = (const GAS f32x4*)g + F.lane;
    f32x4 v[4]; float s = 0.f;
#pragma unroll
    for (int j = 0; j < 4; ++j) { v[j] = xr[64 * j]; s += (v[j].x * v[j].x + v[j].y * v[j].y) + (v[j].z * v[j].z + v[j].w * v[j].w); }
    const float r = 1.0f / sqrtf(wave_sum(s) * (1.f / D) + RMS_EPS);
    GAS unsigned long long* o8 = (GAS unsigned long long*)orow + F.lane;
#pragma unroll
    for (int j = 0; j < 4; ++j) { const f32x4 gg = gr[64 * j]; o8[64 * j] = (unsigned long long)pk2(v[j].x * r * gg.x, v[j].y * r * gg.y) | ((unsigned long long)pk2(v[j].z * r * gg.z, v[j].w * r * gg.w) << 32); }
}
__device__ __forceinline__ void p0_prologue(Frame& F) {
    LAS float* scr = (LAS float*)(F.lds + RING_OFF + F.wave * 16384);
    const int gw = F.vcu * NWAVES + F.wave, NGW = F.G * NWAVES;
    constexpr int I_GU = (D / 64) * (NGU / 32), I_DN = (DFF / 64) * (D / 32), I_IN = (D / 64) * (DIN / 32), I_OUT = (D / 64) * (D / 32);
    constexpr int NITEMS = 2 * I_GU + 2 * I_DN + I_IN + I_OUT + 16 + 16 + 32;
    for (int it = gw; it < NITEMS; it += NGW) {
        int r = it;
        if (r < I_GU) { p0_transpose_item(F.in[I_F1GU], D, NGU, F.Wgu1, 1, scr, r, F.lane); continue; } r -= I_GU;
        if (r < I_GU) { p0_transpose_item(F.in[I_F2GU], D, NGU, F.Wgu2, 1, scr, r, F.lane); continue; } r -= I_GU;
        if (r < I_DN) { p0_transpose_item(F.in[I_F1DN], DFF, D, F.Wdn1, 0, scr, r, F.lane); continue; } r -= I_DN;
        if (r < I_DN) { p0_transpose_item(F.in[I_F2DN], DFF, D, F.Wdn2, 0, scr, r, F.lane); continue; } r -= I_DN;
        if (r < I_IN) { p0_transpose_item(F.in[I_WIN], D, DIN, F.Win, 0, scr, r, F.lane); continue; } r -= I_IN;
        if (r < I_OUT) { p0_transpose_item(F.in[I_WOUT], D, D, F.Wout, 0, scr, r, F.lane); continue; } r -= I_OUT;
        bf16* lora = (bf16*)(F.ws + WS_LORA);
        if (r < 16) { p0_transpose_item(F.in[I_WUP], 64, DRW, lora, 0, scr, r, F.lane); continue; } r -= 16;
        if (r < 16) { p0_transpose_item(F.in[I_AUP], 64, DRW, lora + 512 * 64, 0, scr, r, F.lane); continue; } r -= 16;
        p0_transpose_item(F.in[I_GUP], 128, DRW, lora + 2 * 512 * 64, 0, scr, r, F.lane);
    }
    for (int m = gw; m < M; m += NGW) rms_row_to_bf16(F, F.in[I_X] + (size_t)m * D, F.in[I_F1PRE], F.XN + (size_t)m * D);
}
__device__ __forceinline__ void norm_pass(Frame& F, const float* Fm, const float* base, float* out, const float* gpost, float scale, const float* gpre, bf16* xn) {
    const int gw = F.vcu * NWAVES + F.wave, NGW = F.G * NWAVES;
    for (int m = gw; m < M; m += NGW) {
        const GAS f32x4* fr = (const GAS f32x4*)(Fm + (size_t)m * D) + F.lane; const GAS f32x4* br = (const GAS f32x4*)(base + (size_t)m * D) + F.lane;
        const GAS f32x4* gp = (const GAS f32x4*)gpost + F.lane;
        f32x4 f[4], o[4]; float s = 0.f;
#pragma unroll
        for (int j = 0; j < 4; ++j) { f[j] = fr[64 * j]; o[j] = br[64 * j]; s += (f[j].x * f[j].x + f[j].y * f[j].y) + (f[j].z * f[j].z + f[j].w * f[j].w); }
        const float r = scale / sqrtf(wave_sum(s) * (1.f / D) + RMS_EPS);
        float s2 = 0.f;
#pragma unroll
        for (int j = 0; j < 4; ++j) { const f32x4 g = gp[64 * j]; o[j] = o[j] + f[j] * r * g; s2 += (o[j].x * o[j].x + o[j].y * o[j].y) + (o[j].z * o[j].z + o[j].w * o[j].w); }
        GAS f32x4* orow = (GAS f32x4*)(out + (size_t)m * D) + F.lane;
#pragma unroll
        for (int j = 0; j < 4; ++j) orow[64 * j] = o[j];
        if (xn) {
            const float r2 = 1.0f / sqrtf(wave_sum(s2) * (1.f / D) + RMS_EPS);
            const GAS f32x4* gq = (const GAS f32x4*)gpre + F.lane;
            GAS unsigned long long* o8 = (GAS unsigned long long*)(xn + (size_t)m * D) + F.lane;
#pragma unroll
            for (int j = 0; j < 4; ++j) { const f32x4 gg = gq[64 * j]; o8[64 * j] = (unsigned long long)pk2(o[j].x * r2 * gg.x, o[j].y * r2 * gg.y) | ((unsigned long long)pk2(o[j].z * r2 * gg.z, o[j].w * r2 * gg.w) << 32); }
        }
    }
}

struct ConvW { float w[CONVW]; float cb, lw, lb; };
__device__ __forceinline__ void conv_load_w(Frame& F, ConvW& W) {
    const int c = F.tid;
#pragma unroll
    for (int j = 0; j < CONVW; ++j) W.w[j] = F.in[I_CDW][j * DCV + c];
    W.cb = F.in[I_CB][c]; W.lw = F.in[I_CLW][c]; W.lb = F.in[I_CLB][c];
}
__device__ __forceinline__ void conv_unit(Frame& F, const bf16* P, int unit, const ConvW& W) {
    const int b = unit / (SEQ / 32), t0 = (unit % (SEQ / 32)) * 32, c = F.tid;
    LAS float* sG = (LAS float*)(F.lds + RING_OFF);
    LAS float* sRed = sG + 62 * 512;
    const bf16* pb = P + (size_t)b * SEQ * DIN + DSHIFT + c;
#pragma unroll
    for (int half = 0; half < 2; ++half) {
        unsigned short va[31], vg[31];
#pragma unroll
        for (int k = 0; k < 31; ++k) { const int t = t0 - 30 + 31 * half + k; const bf16* pr = pb + (size_t)(t < 0 ? 0 : t) * DIN; va[k] = pr[0]; vg[k] = pr[DCV]; }
#pragma unroll
        for (int k = 0; k < 31; ++k) { const int t = t0 - 30 + 31 * half + k; const float v = bf2f(va[k]) * sigm(bf2f(vg[k])); sG[(31 * half + k) * 512 + c] = (t >= 0) ? v : 0.f; }
    }
#pragma unroll 1
    for (int tt = 0; tt < 32; ++tt) { float a = W.cb;
#pragma unroll
        for (int j = 0; j < CONVW; ++j) a += W.w[j] * sG[(tt + j) * 512 + c];
        sG[tt * 512 + c] = a;
        const float s = wave_sum(a); if (F.lane == 0) sRed[tt * 8 + F.wave] = s; }
    __syncthreads();
#pragma unroll 1
    for (int tt = 0; tt < 32; ++tt) { float s = 0.f;
#pragma unroll
        for (int k = 0; k < 8; ++k) s += sRed[tt * 8 + k];
        sG[tt * 512 + c] -= s * (1.f / DCV); }
    __syncthreads();
#pragma unroll 1
    for (int tt = 0; tt < 32; ++tt) { const float d = sG[tt * 512 + c]; const float s = wave_sum(d * d); if (F.lane == 0) sRed[tt * 8 + F.wave] = s; }
    __syncthreads();
#pragma unroll 1
    for (int tt = 0; tt < 32; ++tt) { float s = 0.f;
#pragma unroll
        for (int k = 0; k < 8; ++k) s += sRed[tt * 8 + k];
        const float v = sG[tt * 512 + c] * (1.0f / sqrtf(s * (1.f / DCV) + LN_EPS)) * W.lw + W.lb;
        F.OAB[(size_t)(b * SEQ + t0 + tt) * D + DRW + c] = (bf16)f2bf(v * sigm(v)); }
    __syncthreads();
}

constexpr int LS = 72;
constexpr int SLOT = 64 * LS * 2;
constexpr int O_RT = 0, O_ZT = SLOT, O_BT = 2 * SLOT, O_KT = 3 * SLOT, O_ZTT = 4 * SLOT, O_VT = 5 * SLOT, O_BHT = 6 * SLOT, O_KHT = 7 * SLOT;
constexpr int O_U0T = O_ZT, O_X1T = O_BT, O_WZT = O_KT;
constexpr int O_LZK = 8 * SLOT, O_LRB = 9 * SLOT, O_LRK = 10 * SLOT, O_TL = 11 * SLOT;
constexpr int LTS = 68;
constexpr int O_LT = 12 * SLOT;
constexpr int SS = 40;
constexpr int O_L10 = O_LT + 64 * LTS * 4, O_T00T = O_L10 + 32 * SS * 2, O_XT = O_T00T + 64 * SS * 2, O_PC = O_XT + 32 * SS * 2, O_TOT = O_PC + 256, O_AEND = O_TOT + 2048;
constexpr int O_LDF = 0, O_AAF = 64 * 65 * 4, O_GGF = 2 * 64 * 65 * 4;
constexpr int O_TX = 8 * SLOT, O_XA = 9 * SLOT, O_SG = 10 * SLOT;
constexpr int SGS = 136;
static_assert(O_GGF + 64 * 65 * 4 <= 8 * SLOT && O_SG + 64 * SGS * 2 <= O_LT && O_AEND <= RING_BYTES, "rwkv LDS map");

typedef float f32x4v __attribute__((ext_vector_type(4)));
__device__ __forceinline__ f32x4 mfma16(bf16x8 a, bf16x8 b, f32x4 c) { return __builtin_amdgcn_mfma_f32_16x16x32_bf16(a, b, c, 0, 0, 0); }
__device__ __forceinline__ f32x4 mm16(const LAS bf16* A, int lda, const LAS bf16* B, int ldb, int tm, int tn, int nks, int lane, f32x4 acc) {
    const LAS bf16* ap = A + (16 * tm + (lane & 15)) * lda + 8 * (lane >> 4);
    const LAS bf16* bp = B + (16 * tn + (lane & 15)) * ldb + 8 * (lane >> 4);
#pragma unroll
    for (int ks = 0; ks < 2; ++ks) if (ks < nks) acc = mfma16(*(const LAS bf16x8*)(ap + 32 * ks), *(const LAS bf16x8*)(bp + 32 * ks), acc);
    return acc;
}
typedef unsigned u32x2 __attribute__((ext_vector_type(2)));
__device__ __forceinline__ u32x2 pack4(f32x4 v) { u32x2 r; r.x = pk2(v[0], v[1]); r.y = pk2(v[2], v[3]); return r; }
__device__ __forceinline__ void wr_nat(LAS bf16* W, int ldw, int tm, int tn, int lane, f32x4 v) { *(LAS u32x2*)(W + (16 * tn + (lane & 15)) * ldw + 16 * tm + 4 * (lane >> 4)) = pack4(v); }
__device__ __forceinline__ float fast_tanh(float x) { const float e = __expf(2.0f * x); return 1.0f - 2.0f / (e + 1.0f); }
#define WG_BAR() do { asm volatile("s_waitcnt lgkmcnt(0)" ::: "memory"); __builtin_amdgcn_s_barrier(); asm volatile("" ::: "memory"); } while (0)

#ifndef INV_PF_MAX
#define INV_PF_MAX 5
#endif
template <int S> struct InvStep {
    static constexpr int T0 = ((S + 1) >> 2) << 2, N4 = (32 - T0) / 4;
    static __device__ __forceinline__ void load(f32x4 (&v)[8], const LAS float* Lb) {
#pragma unroll
        for (int k = 0; k < N4; ++k) v[k] = *(const LAS f32x4*)(Lb + S * LTS + T0 + 4 * k);
    }
    static __device__ __forceinline__ void run(float (&x)[32], const LAS float* Lb, const f32x4 (&cur)[8]) {
        f32x4 nxt[8];
        InvStep<S + 1>::load(nxt, Lb);
        asm volatile("" ::: "memory");
        const float xs = x[S];
#pragma unroll
        for (int k = 0; k < N4; ++k)
#pragma unroll
            for (int r = 0; r < 4; ++r) if (T0 + 4 * k + r > S) asm volatile("v_fmac_f32 %0, %1, %2" : "+v"(x[T0 + 4 * k + r]) : "v"(cur[k][r]), "v"(xs));
        InvStep<S + 1>::run(x, Lb, nxt);
    }
};
template <> struct InvStep<31> { static __device__ __forceinline__ void load(f32x4 (&)[8], const LAS float*) {} static __device__ __forceinline__ void run(float (&)[32], const LAS float*, const f32x4 (&)[8]) {} };
#define LAUNDER_IDX() int lane = lane0, w = w0; asm volatile("" : "+v"(lane)); asm volatile("" : "+s"(w)); const int q4 = lane >> 4, l15 = lane & 15; (void)q4; (void)l15
#ifndef PROBE_STAGE
#define PROBE_STAGE -1
#endif
#define SREP(k) for (int srep_ = 0; srep_ < ((PROBE_STAGE) == (k) ? 2 : 1); ++srep_)
struct PrepRaw { unsigned v[7][9]; float mu[7]; };
__device__ __forceinline__ void rwkv_prep_issue(Frame& F, const bf16* P, int b, int c, int h, PrepRaw& R) {
    const int lane0 = F.lane, w0 = F.wave; LAUNDER_IDX();
    const int cols[7] = {h * 64 + lane, DRW + h * 64 + lane, 2 * DRW + h * 64 + lane, 3 * DRW + lane, 3 * DRW + 64 + lane, 3 * DRW + 128 + lane, 3 * DRW + 192 + lane};
    const size_t row0 = (size_t)b * SEQ + c * 64 + 8 * w;
    const long poff = (c * 64 + 8 * w > 0) ? -(long)DIN : 0;
#pragma unroll
    for (int g = 0; g < 7; ++g) { const bf16* pc = P + row0 * DIN + cols[g];
        R.mu[g] = F.in[I_MU][cols[g]];
        R.v[g][0] = pc[poff];
#pragma unroll
        for (int i = 0; i < 8; ++i) R.v[g][i + 1] = pc[(size_t)i * DIN]; }
}
__device__ __forceinline__ void rwkv_prep_unit(Frame& F, const bf16* P, int b, int c, int h, PrepRaw& R, int nb, int nc, int nh) {
    const int lane0 = F.lane, w0 = F.wave;
    LAS unsigned char* L = F.lds + RING_OFF;
    LAS bf16* Rt = (LAS bf16*)(L + O_RT); LAS bf16* Zt = (LAS bf16*)(L + O_ZT); LAS bf16* Bt = (LAS bf16*)(L + O_BT); LAS bf16* Kt = (LAS bf16*)(L + O_KT);
    LAS bf16* ZtT = (LAS bf16*)(L + O_ZTT); LAS bf16* VT = (LAS bf16*)(L + O_VT); LAS bf16* BhT = (LAS bf16*)(L + O_BHT); LAS bf16* KhT = (LAS bf16*)(L + O_KHT);
    LAS bf16* U0T = (LAS bf16*)(L + O_U0T); LAS bf16* X1T = (LAS bf16*)(L + O_X1T); LAS bf16* WzT = (LAS bf16*)(L + O_WZT);
    LAS bf16* Lzk = (LAS bf16*)(L + O_LZK); LAS bf16* Lrb = (LAS bf16*)(L + O_LRB); LAS bf16* Lrk = (LAS bf16*)(L + O_LRK); LAS bf16* Tl = (LAS bf16*)(L + O_TL);
    LAS float* LT = (LAS float*)(L + O_LT); LAS bf16* L10 = (LAS bf16*)(L + O_L10); LAS bf16* T00T = (LAS bf16*)(L + O_T00T); LAS bf16* XT = (LAS bf16*)(L + O_XT);
    LAS float* PCv = (LAS float*)(L + O_PC); LAS float* TOT = (LAS float*)(L + O_TOT);
    LAS float* LDf = (LAS float*)(L + O_LDF); LAS float* AAf = (LAS float*)(L + O_AAF); LAS float* GGf = (LAS float*)(L + O_GGF);
    LAS bf16* TX = (LAS bf16*)(L + O_TX); LAS bf16* XA = (LAS bf16*)(L + O_XA); LAS bf16* SG = (LAS bf16*)(L + O_SG);
    unsigned char* ws = F.ws;
    const bf16* WupT = (const bf16*)(ws + WS_LORA); const bf16* AupT = WupT + 512 * 64; const bf16* GupT = AupT + 512 * 64;
    const int unit = (b * NH + h) * NCH + c;
    bf16* MTg = (bf16*)(ws + WS_MT) + (size_t)unit * 4096; bf16* NTg = (bf16*)(ws + WS_NT) + (size_t)unit * 4096;
    bf16* RZg = (bf16*)(ws + WS_RZ) + (size_t)unit * 4096; bf16* Y0g = (bf16*)(ws + WS_Y0) + (size_t)unit * 4096;
    bf16* ETg = (bf16*)(ws + WS_ET) + (size_t)unit * 4096; bf16* GWg = (bf16*)(ws + WS_GW) + (size_t)unit * 4096;
    const int tl0 = c * 64;

    bf16x8 fWu[2][2], fAu[2][2], fGu[2][4]; float cW0[2], cA0[2], cKK, cKA, cRK, cGW, cGB;
    {
        LAUNDER_IDX();
#pragma unroll
        for (int tt = 0; tt < 2; ++tt) { const int gj = h * 64 + 16 * (2 * (w & 1) + tt) + l15;
            const bf16* wu = WupT + (size_t)gj * 64 + 8 * q4; const bf16* au = AupT + (size_t)gj * 64 + 8 * q4; const bf16* gu = GupT + (size_t)gj * 128 + 8 * q4;
#pragma unroll
            for (int ks = 0; ks < 2; ++ks) { fWu[tt][ks] = *(const GAS bf16x8*)(wu + 32 * ks); fAu[tt][ks] = *(const GAS bf16x8*)(au + 32 * ks); }
#pragma unroll
            for (int ks = 0; ks < 4; ++ks) fGu[tt][ks] = *(const GAS bf16x8*)(gu + 32 * ks);
            cW0[tt] = F.in[I_W0][gj]; cA0[tt] = F.in[I_A0][gj]; }
        const int hj = h * 64 + lane;
        cKK = F.in[I_KK][hj]; cKA = F.in[I_KA][hj]; cRK = F.in[I_RK][hj]; cGW = F.in[I_GNW][hj]; cGB = F.in[I_GNB][hj];
    }
    SREP(0) {
    float rr[8], kx[8], vv[8];
    {
        LAUNDER_IDX();
        const bool hasprev = (tl0 + 8 * w) > 0;
#pragma unroll
        for (int g = 0; g < 7; ++g) {
            const float mu = R.mu[g];
            float prev = hasprev ? __uint_as_float(R.v[g][0] << 16) : 0.f;
#pragma unroll
            for (int i = 0; i < 8; ++i) {
                const float cur = __uint_as_float(R.v[g][i + 1] << 16); const float v = cur + (prev - cur) * mu; prev = cur;
                if (g == 0) rr[i] = v; else if (g == 1) kx[i] = v; else if (g == 2) vv[i] = v;
                else if (g == 3) TX[(8 * w + i) * LS + lane] = (bf16)f2bf(fast_tanh(v));
                else if (g == 4) XA[(8 * w + i) * LS + lane] = (bf16)f2bf(v);
                else SG[(8 * w + i) * SGS + (g - 5) * 64 + lane] = (bf16)f2bf(sigm(v));
            }
        }
    }
    WG_BAR();
    {
        LAUNDER_IDX();
        const int tm = w >> 1;
#pragma unroll
        for (int tt = 0; tt < 2; ++tt) { const int tn = 2 * (w & 1) + tt; const int j = 16 * tn + l15;
            f32x4 aD = {0.f, 0.f, 0.f, 0.f}, aA = aD, aG = aD;
            const LAS bf16* txp = TX + (16 * tm + l15) * LS + 8 * q4; const LAS bf16* xap = XA + (16 * tm + l15) * LS + 8 * q4; const LAS bf16* sgp = SG + (16 * tm + l15) * SGS + 8 * q4;
#pragma unroll
            for (int ks = 0; ks < 2; ++ks) { aD = mfma16(*(const LAS bf16x8*)(txp + 32 * ks), fWu[tt][ks], aD); aA = mfma16(*(const LAS bf16x8*)(xap + 32 * ks), fAu[tt][ks], aA); }
#pragma unroll
            for (int ks = 0; ks < 4; ++ks) aG = mfma16(*(const LAS bf16x8*)(sgp + 32 * ks), fGu[tt][ks], aG);
#pragma unroll
            for (int r = 0; r < 4; ++r) { const int t = 16 * tm + 4 * q4 + r;
                LDf[t * 65 + j] = -DECAY_SCALE * sigm(aD[r] + cW0[tt]); AAf[t * 65 + j] = sigm(aA[r] + cA0[tt]); GGf[t * 65 + j] = aG[r]; }
        }
    }
    WG_BAR();
    {
        LAUNDER_IDX();
        float ld[8], aa[8], cl[8], gg[8];
#pragma unroll
        for (int i = 0; i < 8; ++i) { ld[i] = LDf[(8 * w + i) * 65 + lane]; aa[i] = AAf[(8 * w + i) * 65 + lane]; gg[i] = GGf[(8 * w + i) * 65 + lane]; }
        cl[0] = ld[0];
#pragma unroll
        for (int i = 1; i < 8; ++i) cl[i] = cl[i - 1] + ld[i];
        TOT[w * 64 + lane] = cl[7];
        const float kkj = cKK, kaj = cKA, rkj = cRK;
        float kn[8], kp[8], ev[8];
#pragma unroll
        for (int i = 0; i < 8; ++i) { const float kr = kx[i] * kkj; const float ss = wave_sum(kr * kr); kn[i] = kr * (1.0f / sqrtf(fmaxf(ss, 1e-12f)));
            kp[i] = kx[i] * (1.0f + (aa[i] - 1.0f) * kaj);
            const float bon = wave_sum(rr[i] * kp[i] * rkj); ev[i] = (cGB + bon * vv[i]) * gg[i]; gg[i] *= cGW; }
        { v4u o;
          o.x = pk2(ev[0], ev[1]); o.y = pk2(ev[2], ev[3]); o.z = pk2(ev[4], ev[5]); o.w = pk2(ev[6], ev[7]); *(GAS v4u*)(ETg + lane * 64 + 8 * w) = o;
          o.x = pk2(gg[0], gg[1]); o.y = pk2(gg[2], gg[3]); o.z = pk2(gg[4], gg[5]); o.w = pk2(gg[6], gg[7]); *(GAS v4u*)(GWg + lane * 64 + 8 * w) = o; }
        WG_BAR();
        float off = 0.f, tot = 0.f;
#pragma unroll
        for (int k = 0; k < 8; ++k) { const float tv = TOT[k * 64 + lane]; tot += tv; if (k < w) off += tv; }
        float zt[8], bh[8], kh[8];
#pragma unroll
        for (int i = 0; i < 8; ++i) { const float cli = cl[i] + off; const float eL = __expf(cli), eLm = __expf(cli - ld[i]), ieL = __expf(-cli), eC = __expf(tot - cli);
            const float ka = kn[i] * aa[i]; const int t = 8 * w + i;
            zt[i] = -kn[i] * eLm; bh[i] = ka * eC; kh[i] = kp[i] * eC;
            Rt[t * LS + lane] = (bf16)f2bf(rr[i] * eL); Zt[t * LS + lane] = (bf16)f2bf(zt[i]); Bt[t * LS + lane] = (bf16)f2bf(ka * ieL); Kt[t * LS + lane] = (bf16)f2bf(kp[i] * ieL); }
        v4u o;
        o.x = pk2(zt[0], zt[1]); o.y = pk2(zt[2], zt[3]); o.z = pk2(zt[4], zt[5]); o.w = pk2(zt[6], zt[7]); *(LAS v4u*)(ZtT + lane * LS + 8 * w) = o;
        o.x = pk2(vv[0], vv[1]); o.y = pk2(vv[2], vv[3]); o.z = pk2(vv[4], vv[5]); o.w = pk2(vv[6], vv[7]); *(LAS v4u*)(VT + lane * LS + 8 * w) = o;
        o.x = pk2(bh[0], bh[1]); o.y = pk2(bh[2], bh[3]); o.z = pk2(bh[4], bh[5]); o.w = pk2(bh[6], bh[7]); *(LAS v4u*)(BhT + lane * LS + 8 * w) = o;
        o.x = pk2(kh[0], kh[1]); o.y = pk2(kh[2], kh[3]); o.z = pk2(kh[4], kh[5]); o.w = pk2(kh[6], kh[7]); *(LAS v4u*)(KhT + lane * LS + 8 * w) = o;
        if (w == 0) PCv[lane] = __expf(tot);
    }
    WG_BAR();
    }
    SREP(3) {
    LAUNDER_IDX();
#pragma unroll 1
    for (int q = w; q < 64; q += 8) {
        const int p = q >> 4, tm = (q >> 2) & 3, tn = q & 3;
        const f32x4 z4 = {0.f, 0.f, 0.f, 0.f};
        if (p == 0) {
            f32x4 a = mm16(Zt, LS, Bt, LS, tm, tn, 2, lane, z4);
            const int s = 16 * tn + l15, t0 = 16 * tm + 4 * q4;
#pragma unroll
            for (int r = 0; r < 4; ++r) a[r] = (t0 + r > s) ? a[r] : 0.f;
            *(LAS f32x4*)(LT + s * LTS + t0) = a;
            if (tm >= 2 && tn < 2) {
#pragma unroll
                for (int r = 0; r < 4; ++r) L10[(t0 + r - 32) * SS + s] = (bf16)f2bf(a[r]); }
        } else {
            const LAS bf16* A = (p == 2) ? Bt : Kt; const LAS bf16* B = (p == 1) ? Zt : Rt; LAS bf16* W = (p == 1) ? Lzk : (p == 2) ? Lrb : Lrk;
            f32x4 a = mm16(A, LS, B, LS, tm, tn, 2, lane, z4);
            const int t = 16 * tn + l15, s0 = 16 * tm + 4 * q4;
#pragma unroll
            for (int r = 0; r < 4; ++r) { const bool keep = (p == 1) ? (t > s0 + r) : (t >= s0 + r); a[r] = keep ? a[r] : 0.f; }
            wr_nat(W, LS, tm, tn, lane, a);
        }
    }
    }
    WG_BAR();
    SREP(4) {
    LAUNDER_IDX();
    if (w == 0) {
        const int blk = lane >> 5, cc = lane & 31;
        const LAS float* Lb = LT + (32 * blk) * LTS + 32 * blk;
        float x[32];
#pragma unroll
        for (int t = 0; t < 32; ++t) x[t] = (t == cc) ? 1.f : 0.f;
        { f32x4 l0[8]; InvStep<0>::load(l0, Lb); InvStep<0>::run(x, Lb, l0); }
#pragma unroll
        for (int t = 0; t < 32; ++t) Tl[(32 * blk + t) * LS + 32 * blk + cc] = (bf16)f2bf(x[t]);
#pragma unroll
        for (int g = 0; g < 4; ++g) { v4u o; o.x = pk2(x[8 * g], x[8 * g + 1]); o.y = pk2(x[8 * g + 2], x[8 * g + 3]); o.z = pk2(x[8 * g + 4], x[8 * g + 5]); o.w = pk2(x[8 * g + 6], x[8 * g + 7]);
            *(LAS v4u*)(T00T + lane * SS + 8 * g) = o; }
    } else if (w == 1) {
        const int t = lane >> 1, hf = lane & 1; const v4u z = {0u, 0u, 0u, 0u};
        *(LAS v4u*)(Tl + t * LS + 32 + 16 * hf) = z; *(LAS v4u*)(Tl + t * LS + 32 + 16 * hf + 8) = z;
    } else {
#pragma unroll 1
        for (int q = w - 2; q < 16; q += 6) { const int tm = q >> 2, tn = q & 3; const f32x4 z4 = {0.f, 0.f, 0.f, 0.f};
            wr_nat(X1T, LS, tm, tn, lane, mm16(Lzk, LS, VT, LS, tm, tn, 2, lane, z4)); }
    }
    }
    WG_BAR();
    rwkv_prep_issue(F, P, nb, nc, nh, R);
    { LAUNDER_IDX();
    if (w < 4) { const int tm = w >> 1, tn = w & 1; const f32x4 z4 = {0.f, 0.f, 0.f, 0.f};
        wr_nat(XT, SS, tm, tn, lane, mm16(L10, SS, T00T, SS, tm, tn, 1, lane, z4)); } }
    WG_BAR();
    { LAUNDER_IDX();
    if (w < 4) { const int tm = w >> 1, tn = w & 1; const f32x4 z4 = {0.f, 0.f, 0.f, 0.f};
        const f32x4 a = mm16(XT, SS, Tl + 32 * LS + 32, LS, tm, tn, 1, lane, z4);
        *(LAS u32x2*)(Tl + (32 + 16 * tn + l15) * LS + 16 * tm + 4 * q4) = pack4(a); } }
    WG_BAR();
    SREP(7) { LAUNDER_IDX();
#pragma unroll 1
    for (int q = w; q < 32; q += 8) { const int p = q >> 4, tm = (q >> 2) & 3, tn = q & 3; const f32x4 z4 = {0.f, 0.f, 0.f, 0.f};
        if (p == 0) wr_nat(WzT, LS, tm, tn, lane, mm16(Tl, LS, ZtT, LS, tm, tn, 2, lane, z4));
        else wr_nat(U0T, LS, tm, tn, lane, mm16(Tl, LS, X1T, LS, tm, tn, 2, lane, z4)); } }
    WG_BAR();
    SREP(8) { LAUNDER_IDX();
#pragma unroll 1
    for (int q = w; q < 64; q += 8) { const int p = q >> 4, tm = (q >> 2) & 3, tn = q & 3; const f32x4 z4 = {0.f, 0.f, 0.f, 0.f};
        const int n = 16 * tn + l15, m0 = 16 * tm + 4 * q4; f32x4 a; bf16* dst;
        if (p == 0) { a = mm16(WzT, LS, BhT, LS, tm, tn, 2, lane, z4);
            const float pc = PCv[n];
#pragma unroll
            for (int r = 0; r < 4; ++r) if (m0 + r == n) a[r] += pc;
            dst = MTg; }
        else if (p == 1) { a = mm16(BhT, LS, U0T, LS, tm, tn, 2, lane, z4); a = mm16(KhT, LS, VT, LS, tm, tn, 2, lane, a); dst = NTg; }
        else if (p == 2) { a = mm16(WzT, LS, Lrb, LS, tm, tn, 2, lane, z4);
            const u32x2 rv = *(const LAS u32x2*)(Rt + n * LS + m0);
            a[0] += __uint_as_float(rv.x << 16); a[1] += __uint_as_float(rv.x & 0xffff0000u); a[2] += __uint_as_float(rv.y << 16); a[3] += __uint_as_float(rv.y & 0xffff0000u);
            dst = RZg; }
        else { a = mm16(Lrb, LS, U0T, LS, tm, tn, 2, lane, z4); a = mm16(Lrk, LS, VT, LS, tm, tn, 2, lane, a); dst = Y0g; }
        *(GAS u32x2*)(dst + n * 64 + m0) = pack4(a);
    } }
    WG_BAR();
}

__device__ __forceinline__ float row16_sum(float v) {
    v += __builtin_bit_cast(float, __builtin_amdgcn_update_dpp(0, __builtin_bit_cast(int, v), 0xB1, 0xF, 0xF, true));
    v += __builtin_bit_cast(float, __builtin_amdgcn_update_dpp(0, __builtin_bit_cast(int, v), 0x4E, 0xF, 0xF, true));
    v += __builtin_bit_cast(float, __builtin_amdgcn_update_dpp(0, __builtin_bit_cast(int, v), 0x141, 0xF, 0xF, true));
    v += __builtin_bit_cast(float, __builtin_amdgcn_update_dpp(0, __builtin_bit_cast(int, v), 0x140, 0xF, 0xF, true));
    return v;
}
__device__ __forceinline__ f32x4 unpack4(u32x2 v) { f32x4 r; r[0] = __uint_as_float(v.x << 16); r[1] = __uint_as_float(v.x & 0xffff0000u); r[2] = __uint_as_float(v.y << 16); r[3] = __uint_as_float(v.y & 0xffff0000u); return r; }
struct ScanRegs { bf16x8 a0, a1; u32x2 ini[4], e[4], g[4]; };
__device__ __forceinline__ void scan_load(ScanRegs& R, const bf16* Ag, const bf16* Ig, const bf16* Eg, const bf16* Gg, int c, int tm, int lane, bool isY) {
    const int q4 = lane >> 4, l15 = lane & 15;
    const bf16* Au = Ag + (size_t)c * 4096 + (16 * tm + l15) * 64 + 8 * q4; const size_t io = (size_t)c * 4096 + 16 * tm + 4 * q4;
    R.a0 = *(const GAS bf16x8*)Au; R.a1 = *(const GAS bf16x8*)(Au + 32);
#pragma unroll
    for (int tn = 0; tn < 4; ++tn) R.ini[tn] = *(const GAS u32x2*)(Ig + io + (16 * tn + l15) * 64);
    if (isY) {
#pragma unroll
        for (int tn = 0; tn < 4; ++tn) { R.e[tn] = *(const GAS u32x2*)(Eg + io + (16 * tn + l15) * 64); R.g[tn] = *(const GAS u32x2*)(Gg + io + (16 * tn + l15) * 64); } }
}
__device__ __forceinline__ void rwkv_scan(Frame& F, int bh) {
    const int b = bh >> 3, h = bh & 7, lane = F.lane, w = F.wave, q4 = lane >> 4, l15 = lane & 15;
    LAS bf16* SB0 = (LAS bf16*)(F.lds + RING_OFF); LAS bf16* SB1 = SB0 + 64 * LS;
    unsigned char* ws = F.ws;
    const size_t ubase = (size_t)(b * NH + h) * NCH;
    const bool isY = w < 4; const int tm = w & 3;
    const bf16* Ag = (const bf16*)(ws + (isY ? WS_RZ : WS_MT)) + ubase * 4096; const bf16* Ig = (const bf16*)(ws + (isY ? WS_Y0 : WS_NT)) + ubase * 4096;
    const bf16* Eg = (const bf16*)(ws + WS_ET) + ubase * 4096; const bf16* Gg = (const bf16*)(ws + WS_GW) + ubase * 4096;
    ScanRegs cur, nxt;
    scan_load(cur, Ag, Ig, Eg, Gg, 0, tm, lane, isY);
    for (int u = F.tid; u < 64 * LS / 2; u += NWAVES * 64) ((LAS unsigned*)SB0)[u] = 0u;
    WG_BAR();
#pragma unroll 1
    for (int c = 0; c < NCH; ++c) {
        const LAS bf16* Sc = (c & 1) ? SB1 : SB0; LAS bf16* Sn = (c & 1) ? SB0 : SB1;
        scan_load(nxt, Ag, Ig, Eg, Gg, (c + 1 < NCH) ? c + 1 : c, tm, lane, isY);
        f32x4 acc[4];
#pragma unroll
        for (int tn = 0; tn < 4; ++tn) acc[tn] = unpack4(cur.ini[tn]);
#pragma unroll
        for (int tn = 0; tn < 4; ++tn) { const LAS bf16* bp = Sc + (16 * tn + l15) * LS + 8 * q4;
            acc[tn] = mfma16(cur.a0, *(const LAS bf16x8*)bp, acc[tn]); acc[tn] = mfma16(cur.a1, *(const LAS bf16x8*)(bp + 32), acc[tn]); }
        if (!isY) {
#pragma unroll
            for (int tn = 0; tn < 4; ++tn) *(LAS u32x2*)(Sn + (16 * tn + l15) * LS + 16 * tm + 4 * q4) = pack4(acc[tn]);
        } else {
            const size_t tg0 = (size_t)b * SEQ + c * 64 + 16 * tm + 4 * q4;
            f32x4 ev[4], gv[4];
#pragma unroll
            for (int tn = 0; tn < 4; ++tn) { ev[tn] = unpack4(cur.e[tn]); gv[tn] = unpack4(cur.g[tn]); }
#pragma unroll
            for (int r = 0; r < 4; ++r) {
                const float s = row16_sum((acc[0][r] + acc[1][r]) + (acc[2][r] + acc[3][r])); const float mean = s * (1.f / 64.f);
                float d[4], qq = 0.f;
#pragma unroll
                for (int tn = 0; tn < 4; ++tn) { d[tn] = acc[tn][r] - mean; qq += d[tn] * d[tn]; }
                const float rstd = 1.0f / sqrtf(row16_sum(qq) * (1.f / 64.f) + GN_EPS);
#pragma unroll
                for (int tn = 0; tn < 4; ++tn) F.OAB[(tg0 + r) * D + h * 64 + 16 * tn + l15] = (bf16)f2bf(d[tn] * rstd * gv[tn][r] + ev[tn][r]);
            }
        }
        WG_BAR();
        cur = nxt;
    }
}

struct Args { const float* in[28]; float* out; unsigned char* ws; int ph_lo, ph_hi; };
__global__ void __launch_bounds__(NWAVES * 64, 2) mk_fwd(Args args) {
    extern __shared__ __attribute__((aligned(16))) unsigned char lds[];
    Frame F;
    F.lds = (LAS unsigned char*)lds;
    F.MISC = (volatile LAS unsigned*)(F.lds + MISC_OFF);
    F.tid = threadIdx.x; F.lane = F.tid & 63; F.wave = __builtin_amdgcn_readfirstlane(F.tid >> 6);
    F.G = gridDim.x; { const int bx = blockIdx.x; F.vcu = (F.G % 8 == 0) ? (bx % 8) * (F.G / 8) + bx / 8 : bx; }
    unsigned char* ws = args.ws;
    F.ctl = (gu32*)(ws + WS_CTL); F.ws = ws;
#pragma unroll
    for (int i = 0; i < 28; ++i) F.in[i] = args.in[i];
    F.out = args.out;
    F.Wgu1 = (bf16*)(ws + WS_WGU1); F.Wdn1 = (bf16*)(ws + WS_WDN1); F.Win = (bf16*)(ws + WS_WIN); F.Wout = (bf16*)(ws + WS_WOUT); F.Wgu2 = (bf16*)(ws + WS_WGU2); F.Wdn2 = (bf16*)(ws + WS_WDN2);
    F.XN = (bf16*)(ws + WS_XN); F.H = (bf16*)(ws + WS_H); F.OAB = (bf16*)(ws + WS_OAB); F.Fm = (float*)(ws + WS_F);
    for (int u = F.tid; u < (LDS_BYTES - LDSCTL_OFF) / 4; u += NWAVES * 64) ((LAS unsigned*)(F.lds + LDSCTL_OFF))[u] = 0u;
    __syncthreads();
    XcdBarrier bar; bar.bar = (unsigned*)(F.ctl + CW_BAR); bar.x = 0; bar.st = nullptr;
    if (MK_ONE_LAUNCH) bar = xcd_barrier_post((unsigned*)(F.ctl + CW_BAR), F.MISC + 8);
    const int lo = args.ph_lo, hi = args.ph_hi;
#ifndef PH_MASK
#define PH_MASK 0xFFFF
#endif
#define IN(k) (((PH_MASK >> (k)) & 1) && lo <= (k) && (k) < hi)
#ifndef DBL_MASK
#define DBL_MASK 0
#endif
#define REP(k) for (int rep_ = 0; rep_ < ((((DBL_MASK) >> (k)) & 1) ? 2 : 1); ++rep_)
#define SEAM(k) do { if (IN(k) && IN((k) + 1)) xcd_barrier(bar); } while (0)

    if (IN(0)) REP(0) { p0_prologue(F); } SEAM(0);
    if (IN(1)) REP(1) { pg8::Gemm g{F.XN, F.Wgu1, M, NGU, D}; pg8::StaticOrder S; S.init(M, NGU, F.G, (int)blockIdx.x); pg8::EpiSwiGLU E{F.H, DFF};
        pg8::gemm_phase<pg8::EpiSwiGLU, pg8::StaticOrder, true, true>(F.lds + RING_OFF, g, S, E); } SEAM(1);
    if (IN(2)) REP(2) { pg8::Gemm g{F.H, F.Wdn1, M, D, DFF}; pg8::StaticOrder S; S.init(M, D, F.G, (int)blockIdx.x); pg8::EpiF32 E{F.Fm, D};
        pg8::gemm_phase<pg8::EpiF32, pg8::StaticOrder, true, true>(F.lds + RING_OFF, g, S, E); } SEAM(2);
    if (IN(3)) REP(3) { norm_pass(F, F.Fm, F.in[I_X], F.out, F.in[I_F1POST], 0.5f, F.in[I_MPRE], F.XN); } SEAM(3);
    if (IN(4)) REP(4) { pg8::Gemm g{F.XN, F.Win, M, DIN, D}; pg8::StaticOrder S; S.init(M, DIN, F.G, (int)blockIdx.x); pg8::EpiBf16 E{F.H, DIN};
        pg8::gemm_phase<pg8::EpiBf16, pg8::StaticOrder, true, true>(F.lds + RING_OFF, g, S, E); } SEAM(4);
    if (IN(5)) REP(5) {
        PrepRaw R;
        if (F.vcu < BATCH * NCH) rwkv_prep_issue(F, F.H, F.vcu / NCH, F.vcu % NCH, 0, R);
        for (int pu = F.vcu; pu < BATCH * NCH; pu += F.G) for (int h = 0; h < NH; ++h) {
            int npu = pu, nh = h + 1; if (nh == NH) { nh = 0; npu = pu + F.G; } if (npu >= BATCH * NCH) { npu = pu; nh = h; }
            rwkv_prep_unit(F, F.H, pu / NCH, pu % NCH, h, R, npu / NCH, npu % NCH, nh); }
        asm volatile("s_waitcnt vmcnt(0)" ::: "memory");
    } SEAM(5);
    if (IN(6)) REP(6) {
        if ((int)blockIdx.x < BATCH * NH) rwkv_scan(F, (int)blockIdx.x);
        else { ConvW CW; conv_load_w(F, CW); for (int u = (int)blockIdx.x - BATCH * NH; u < M / 32; u += F.G - BATCH * NH) conv_unit(F, F.H, u, CW); }
    } SEAM(6);
    if (IN(7)) REP(7) { pg8::Gemm g{F.OAB, F.Wout, M, D, D}; pg8::StaticOrder S; S.init(M, D, F.G, (int)blockIdx.x); pg8::EpiF32 E{F.Fm, D};
        pg8::gemm_phase<pg8::EpiF32, pg8::StaticOrder, true, true>(F.lds + RING_OFF, g, S, E); } SEAM(7);
    if (IN(8)) REP(8) { norm_pass(F, F.Fm, F.out, F.out, F.in[I_MPOST], 1.0f, F.in[I_F2PRE], F.XN); } SEAM(8);
    if (IN(9)) REP(9) { pg8::Gemm g{F.XN, F.Wgu2, M, NGU, D}; pg8::StaticOrder S; S.init(M, NGU, F.G, (int)blockIdx.x); pg8::EpiSwiGLU E{F.H, DFF};
        pg8::gemm_phase<pg8::EpiSwiGLU, pg8::StaticOrder, true, true>(F.lds + RING_OFF, g, S, E); } SEAM(9);
    if (IN(10)) REP(10) { pg8::Gemm g{F.H, F.Wdn2, M, D, DFF}; pg8::StaticOrder S; S.init(M, D, F.G, (int)blockIdx.x); pg8::EpiF32 E{F.Fm, D};
        pg8::gemm_phase<pg8::EpiF32, pg8::StaticOrder, true, true>(F.lds + RING_OFF, g, S, E); } SEAM(10);
    if (IN(11)) REP(11) { norm_pass(F, F.Fm, F.out, F.out, F.in[I_F2POST], 0.5f, nullptr, nullptr); }
#undef IN
#undef SEAM
}

extern "C" void kernel_launch(void* const* d_in, const int* in_sizes, int n_in, void* d_out, int out_size, void* d_ws, size_t ws_size, hipStream_t stream) {
    static int grid = 0;
    if (grid == 0) {
        if (n_in != 28 || in_sizes[0] != M * D || out_size != M * D || ws_size < WS_END) { fprintf(stderr, "kernel_launch: unexpected shapes (n_in %d, in0 %d, out %d, ws %zu); nothing launched\n", n_in, n_in > 0 ? in_sizes[0] : -1, out_size, ws_size); grid = -1; return; }
        int dev = 0, cus = 0, per_cu = 0;
        if (hipGetDevice(&dev) != hipSuccess || hipDeviceGetAttribute(&cus, hipDeviceAttributeMultiprocessorCount, dev) != hipSuccess) { grid = -1; return; }
        if (hipFuncSetAttribute((const void*)mk_fwd, hipFuncAttributeMaxDynamicSharedMemorySize, LDS_BYTES) != hipSuccess) { fprintf(stderr, "kernel_launch: hipFuncSetAttribute failed\n"); grid = -1; return; }
        if (hipOccupancyMaxActiveBlocksPerMultiprocessor(&per_cu, (const void*)mk_fwd, NWAVES * 64, LDS_BYTES) != hipSuccess || per_cu < 1) { fprintf(stderr, "kernel_launch: occupancy query says %d blocks per CU; nothing launched\n", per_cu); (void)hipGetLastError(); grid = -1; return; }
        grid = cus;
    }
    if (grid < 0) return;
    if (hipMemsetAsync((char*)d_ws + WS_CTL, 0, CTL_ZERO_BYTES, stream) != hipSuccess) { fprintf(stderr, "kernel_launch: hipMemsetAsync failed\n"); return; }
    Args a{};
    for (int i = 0; i < 28; ++i) a.in[i] = (const float*)d_in[i];
    a.out = (float*)d_out; a.ws = (unsigned char*)d_ws;
#if MK_ONE_LAUNCH
    a.ph_lo = 0; a.ph_hi = N_PHASES;
    hipLaunchKernelGGL(mk_fwd, dim3(grid), dim3(NWAVES * 64), LDS_BYTES, stream, a);
#else
    for (int p = 0; p < N_PHASES; ++p) { a.ph_lo = p; a.ph_hi = p + 1; hipLaunchKernelGGL(mk_fwd, dim3(grid), dim3(NWAVES * 64), LDS_BYTES, stream, a); }
#endif
    const hipError_t le = hipPeekAtLastError();
    if (le != hipSuccess) fprintf(stderr, "kernel_launch: launch failed: %s\n", hipGetErrorName(le));
}
```

```cpp
#include <hip/hip_runtime.h>
#include <cstdio>
#include <cstdint>
namespace pg8 {
#define PG8_LAS __attribute__((address_space(3)))
typedef unsigned short bf16_t;
typedef short bf16x8 __attribute__((ext_vector_type(8)));
typedef float f32x4 __attribute__((ext_vector_type(4)));
typedef unsigned u32x4 __attribute__((ext_vector_type(4)));
constexpr int BM = 256, BK = 64, HALF = 128, HTB = HALF * BK * 2  , STAGE_BYTES = 8 * HTB, NXCD = 8, WGM = 8;

__host__ __device__ __forceinline__ int lds_byte(int r, int c) { const int st = (r >> 4) * 2 + (c >> 5), rr = r & 15, cc = c & 31, ob = rr * 64 + cc * 2; return st * 1024 + (ob ^ (((ob >> 9) & 1) << 5)); }
__host__ __device__ __forceinline__ void stage_rc(int b, int& R, int& C) { const int st = b / 1024, sb = b % 1024, swz = sb ^ (((sb >> 9) & 1) << 5); R = (st >> 1) * 16 + swz / 64; C = (st & 1) * 32 + (swz % 64) / 2; }
__host__ __device__ __forceinline__ int perm32(int rho) { const int n = rho >> 4, i = rho & 15; return 8 * (i >> 2) + 4 * n + (i & 3); }

struct Unit { int pm, pn; };
struct Gemm { const bf16_t* A; const bf16_t* Bt; int M, N, K; };

struct StaticOrder {
    int nM, nN, nwg, G, c;
    __host__ __device__ void init(int M, int N, int G_, int c_) { nM = M / BM; nN = N / BM; nwg = nM * nN; G = G_; c = c_; }
    __host__ __device__ bool next(int i, Unit& u) const {
        const long L = (long)i * G + c; if (L >= nwg) return false;
        int wgid = (int)L; { const int q = nwg / NXCD, r = nwg % NXCD, xcd = wgid % NXCD, off = wgid / NXCD; wgid = (xcd < r ? xcd * (q + 1) : r * (q + 1) + (xcd - r) * q) + off; }
        const int nig = WGM * nN, gid = wgid / nig, fm = gid * WGM, gsz = (nM - fm) < WGM ? (nM - fm) : WGM;
        u.pm = fm + ((wgid % nig) % gsz); u.pn = (wgid % nig) / gsz; return true;
    }
    __device__ __forceinline__ void a_ready(const Unit&) const {}
    __device__ __forceinline__ void done(const Unit&) const {}
};
typedef __bf16 bf16x2n __attribute__((ext_vector_type(2)));
__device__ __forceinline__ unsigned cvt_pk_bf16(float lo, float hi) { bf16x2n v; v.x = (__bf16)lo; v.y = (__bf16)hi; return __builtin_bit_cast(unsigned, v); }
typedef float f32x2 __attribute__((ext_vector_type(2)));
__device__ __forceinline__ float silu_mul(float g, float u) { const float e = __builtin_amdgcn_exp2f(g * -1.44269504f); return g * __builtin_amdgcn_rcpf(1.0f + e) * u; }

struct EpiBf16 {
    static constexpr bool PERM = true, AFTER_DRAIN = false;
    bf16_t* O; int ldc;
    __device__ __forceinline__ void operator()(const f32x4 (&acc)[2][2][4][2], const Unit& u, int wr, int wc, int fr, int fq) const {
        const int row0 = u.pm * BM + wr * 64 + fr; const int col0 = u.pn * BM + wc * 32 + 8 * fq;
#pragma unroll
        for (int ai = 0; ai < 2; ++ai)
#pragma unroll
            for (int m = 0; m < 4; ++m) { bf16_t* rowp = O + (size_t)(row0 + ai * HALF + m * 16) * ldc + col0;
#pragma unroll
                for (int bj = 0; bj < 2; ++bj) { const f32x4 v0 = acc[ai][bj][m][0], v1 = acc[ai][bj][m][1];
                    u32x4 w; w.x = cvt_pk_bf16(v0[0], v0[1]); w.y = cvt_pk_bf16(v0[2], v0[3]); w.z = cvt_pk_bf16(v1[0], v1[1]); w.w = cvt_pk_bf16(v1[2], v1[3]);
                    *(u32x4*)(rowp + bj * HALF) = w; } }
    }
};
struct EpiSwiGLU {
    static constexpr bool PERM = true, AFTER_DRAIN = false;
    bf16_t* H; int ldh;
    __device__ __forceinline__ void operator()(const f32x4 (&acc)[2][2][4][2], const Unit& u, int wr, int wc, int fr, int fq) const {
        const int row0 = u.pm * BM + wr * 64 + fr; const int col0 = u.pn * HALF + wc * 32 + 8 * fq;
#pragma unroll
        for (int ai = 0; ai < 2; ++ai)
#pragma unroll
            for (int m = 0; m < 4; ++m) { bf16_t* rowp = H + (size_t)(row0 + ai * HALF + m * 16) * ldh + col0;
                const f32x4 g0 = acc[ai][0][m][0], g1 = acc[ai][0][m][1], u0 = acc[ai][1][m][0], u1 = acc[ai][1][m][1];
                u32x4 w; w.x = cvt_pk_bf16(silu_mul(g0[0], u0[0]), silu_mul(g0[1], u0[1])); w.y = cvt_pk_bf16(silu_mul(g0[2], u0[2]), silu_mul(g0[3], u0[3]));
                w.z = cvt_pk_bf16(silu_mul(g1[0], u1[0]), silu_mul(g1[1], u1[1])); w.w = cvt_pk_bf16(silu_mul(g1[2], u1[2]), silu_mul(g1[3], u1[3]));
                *(u32x4*)rowp = w; }
    }
};
struct EpiF32 {
    static constexpr bool PERM = false, AFTER_DRAIN = false;
    float* C; int ldc;
    __device__ __forceinline__ void operator()(const f32x4 (&acc)[2][2][4][2], const Unit& u, int wr, int wc, int fr, int fq) const {
        const int row0 = u.pm * BM + wr * 64 + fr, col0 = u.pn * BM + wc * 32 + 4 * fq;
#pragma unroll
        for (int ai = 0; ai < 2; ++ai)
#pragma unroll
            for (int m = 0; m < 4; ++m) { float* rowp = C + (size_t)(row0 + ai * HALF + m * 16) * ldc + col0;
#pragma unroll
                for (int bj = 0; bj < 2; ++bj)
#pragma unroll
                    for (int n = 0; n < 2; ++n) *(f32x4*)(rowp + bj * HALF + n * 16) = acc[ai][bj][m][n]; }
    }
};
template <class Epi, class Sched, bool ALIGN_EPI = false, bool SP2 = false>
__device__ __forceinline__ void gemm_phase(PG8_LAS unsigned char* lds, const Gemm g, const Sched& S, const Epi& E) {
    const int tid = threadIdx.x, wid = __builtin_amdgcn_readfirstlane(tid >> 6), lane = tid & 63, wr = wid >> 2, wc = wid & 3, fr = lane & 15, fq = lane >> 4;
    const int K = g.K, nt = K / BK;
    unsigned voffA[2], voffB[2];
#pragma unroll
    for (int i = 0; i < 2; ++i) { int R, C; stage_rc(tid * 16 + i * 8192, R, C); const int Rb = Epi::PERM ? ((R & ~31) + perm32(R & 31)) : R;
        voffA[i] = (unsigned)(R * K + C) * 2u; voffB[i] = (unsigned)(Rb * K + C) * 2u; }
    const size_t kstep = (size_t)(BK * 2);
    const size_t hstep = (size_t)HALF * K * 2;
    const size_t tstep = 2 * hstep;
    const unsigned ldsw = (unsigned)wid * 1024u;
    const int aoff = lds_byte(wr * 64 + fr, fq * 8), boff = lds_byte(wc * 32 + fr, fq * 8);
#define PG8_SA(b, h) (((b) * 2 + (h)) * HTB)
#define PG8_SB(b, h) ((4 + (b) * 2 + (h)) * HTB)
#define PG8_STAGE(bufoff, gbase, voff) do { _Pragma("unroll") for (int _i = 0; _i < 2; ++_i) \
        __builtin_amdgcn_global_load_lds((const unsigned*)((const char*)(gbase) + (voff)[_i]), (PG8_LAS unsigned*)(lds + (bufoff) + ldsw + _i * 8192), 16, 0, 0); } while (0)
#define PG8_LDA(dst, b, h) do { _Pragma("unroll") for (int m = 0; m < 4; ++m) _Pragma("unroll") for (int k = 0; k < 2; ++k) dst[m][k] = *(const PG8_LAS bf16x8*)(lds + PG8_SA(b, h) + aoff + m * 2048 + k * 1024); } while (0)
#define PG8_LDB(dst, b, h) do { _Pragma("unroll") for (int n = 0; n < 2; ++n) _Pragma("unroll") for (int k = 0; k < 2; ++k) dst[n][k] = *(const PG8_LAS bf16x8*)(lds + PG8_SB(b, h) + boff + n * 2048 + k * 1024); } while (0)
#define PG8_MMA(ai, bj, At, Bt) do { __builtin_amdgcn_s_setprio(1); _Pragma("unroll") for (int m = 0; m < 4; ++m) _Pragma("unroll") for (int n = 0; n < 2; ++n) _Pragma("unroll") for (int k = 0; k < 2; ++k) \
        acc[ai][bj][m][n] = __builtin_amdgcn_mfma_f32_16x16x32_bf16(Bt[n][k], At[m][k], acc[ai][bj][m][n], 0, 0, 0); __builtin_amdgcn_s_setprio(0); } while (0)
#define PG8_WAIT_V(n) asm volatile("s_waitcnt vmcnt(" #n ")" ::: "memory")
#define PG8_WAIT_L(n) asm volatile("s_waitcnt lgkmcnt(" #n ")" ::: "memory")
#define PG8_BAR __builtin_amdgcn_s_barrier()
#define PG8_SCHED __builtin_amdgcn_sched_barrier(0)
    Unit cur, nxt; int ui = 0;
    if (!S.next(0, cur)) return;
    f32x4 acc[2][2][4][2];
#pragma unroll
    for (int a = 0; a < 2; ++a)
#pragma unroll
        for (int b = 0; b < 2; ++b)
#pragma unroll
            for (int m = 0; m < 4; ++m)
#pragma unroll
                for (int n = 0; n < 2; ++n) acc[a][b][m][n] = (f32x4){0.f, 0.f, 0.f, 0.f};
    bf16x8 At[4][2], B0[2][2], B1[2][2];
    const char* cA = (const char*)g.A + (size_t)cur.pm * tstep; const char* cB = (const char*)g.Bt + (size_t)cur.pn * tstep;
    S.a_ready(cur);
    if constexpr (SP2) {
        PG8_STAGE(PG8_SB(0, 0), cB, voffB); PG8_STAGE(PG8_SB(0, 1), cB + hstep, voffB); PG8_STAGE(PG8_SA(0, 0), cA, voffA); PG8_STAGE(PG8_SA(0, 1), cA + hstep, voffA);
        if (wr == 1) PG8_BAR;
        PG8_WAIT_V(2); PG8_BAR;
        PG8_STAGE(PG8_SB(1, 0), cB + kstep, voffB); PG8_STAGE(PG8_SA(1, 0), cA + kstep, voffA); PG8_STAGE(PG8_SB(1, 1), cB + hstep + kstep, voffB);
        PG8_WAIT_V(6); PG8_BAR;
    } else {
        PG8_STAGE(PG8_SB(0, 0), cB, voffB); PG8_STAGE(PG8_SA(0, 0), cA, voffA); PG8_STAGE(PG8_SB(0, 1), cB + hstep, voffB); PG8_STAGE(PG8_SA(0, 1), cA + hstep, voffA);
        if (wr == 1) PG8_BAR;
        PG8_WAIT_V(4); PG8_BAR;
        PG8_STAGE(PG8_SB(1, 0), cB + kstep, voffB); PG8_STAGE(PG8_SA(1, 0), cA + kstep, voffA); PG8_STAGE(PG8_SB(1, 1), cB + hstep + kstep, voffB);
        PG8_WAIT_V(6); PG8_BAR;
    }
    for (;;) {
        const bool has_next = S.next(ui + 1, nxt);
        const char* nA = has_next ? (const char*)g.A + (size_t)nxt.pm * tstep : cA; const char* nB = has_next ? (const char*)g.Bt + (size_t)nxt.pn * tstep : cB;
        for (int t = 0; t < nt; t += 2) {
            const bool last = (t == nt - 2);
            const char* a1 = cA + (size_t)(t + 1) * kstep;
            const char* a2 = last ? nA : cA + (size_t)(t + 2) * kstep; const char* b2 = last ? nB : cB + (size_t)(t + 2) * kstep;
            const char* a3 = a2 + kstep; const char* b3 = b2 + kstep;
            if (last && has_next) S.a_ready(nxt);
            if constexpr (SP2) {
            PG8_LDB(B0, 0, 0); PG8_LDB(B1, 0, 1); PG8_SCHED; PG8_LDA(At, 0, 0); PG8_STAGE(PG8_SA(1, 1), a1 + hstep, voffA);
            PG8_WAIT_V(8); PG8_WAIT_L(0); PG8_BAR; PG8_MMA(0, 0, At, B0); PG8_MMA(0, 1, At, B1); PG8_BAR; PG8_SCHED;
            PG8_LDA(At, 0, 1); PG8_STAGE(PG8_SB(0, 0), b2, voffB); PG8_STAGE(PG8_SB(0, 1), b2 + hstep, voffB); PG8_STAGE(PG8_SA(0, 0), a2, voffA);
            PG8_WAIT_V(8); PG8_WAIT_L(0); PG8_BAR; PG8_MMA(1, 0, At, B0); PG8_MMA(1, 1, At, B1); PG8_BAR; PG8_SCHED;
            PG8_LDB(B0, 1, 0); PG8_LDB(B1, 1, 1); PG8_SCHED; PG8_LDA(At, 1, 0); PG8_STAGE(PG8_SA(0, 1), a2 + hstep, voffA);
            PG8_WAIT_V(8); PG8_WAIT_L(0); PG8_BAR; PG8_MMA(0, 0, At, B0); PG8_MMA(0, 1, At, B1); PG8_BAR; PG8_SCHED;
            PG8_LDA(At, 1, 1); PG8_STAGE(PG8_SB(1, 0), b3, voffB); PG8_STAGE(PG8_SB(1, 1), b3 + hstep, voffB); PG8_STAGE(PG8_SA(1, 0), a3, voffA);
            PG8_WAIT_V(8); PG8_WAIT_L(0); PG8_BAR; PG8_MMA(1, 0, At, B0); PG8_MMA(1, 1, At, B1); PG8_BAR; PG8_SCHED;
            } else {
            PG8_LDB(B0, 0, 0); PG8_SCHED; PG8_LDA(At, 0, 0); PG8_STAGE(PG8_SA(1, 1), a1 + hstep, voffA);
            PG8_WAIT_L(8); PG8_BAR; PG8_WAIT_L(0); PG8_MMA(0, 0, At, B0); PG8_BAR; PG8_SCHED;
            PG8_LDB(B1, 0, 1); PG8_STAGE(PG8_SB(0, 0), b2, voffB);
            PG8_BAR; PG8_WAIT_L(0); PG8_MMA(0, 1, At, B1); PG8_BAR;
            PG8_LDA(At, 0, 1); PG8_STAGE(PG8_SA(0, 0), a2, voffA);
            PG8_BAR; PG8_WAIT_L(0); PG8_MMA(1, 0, At, B0); PG8_BAR; PG8_SCHED;
            PG8_STAGE(PG8_SB(0, 1), b2 + hstep, voffB);
            PG8_WAIT_V(6); PG8_BAR; PG8_MMA(1, 1, At, B1); PG8_BAR;
            PG8_LDB(B0, 1, 0); PG8_SCHED; PG8_LDA(At, 1, 0); PG8_STAGE(PG8_SA(0, 1), a2 + hstep, voffA);
            PG8_WAIT_L(8); PG8_BAR; PG8_WAIT_L(0); PG8_MMA(0, 0, At, B0); PG8_BAR; PG8_SCHED;
            PG8_LDB(B1, 1, 1); PG8_STAGE(PG8_SB(1, 0), b3, voffB);
            PG8_BAR; PG8_WAIT_L(0); PG8_MMA(0, 1, At, B1); PG8_BAR;
            PG8_LDA(At, 1, 1); PG8_STAGE(PG8_SA(1, 0), a3, voffA);
            PG8_BAR; PG8_WAIT_L(0); PG8_MMA(1, 0, At, B0); PG8_BAR; PG8_SCHED;
            PG8_STAGE(PG8_SB(1, 1), b3 + hstep, voffB);
            PG8_WAIT_V(6); PG8_BAR; PG8_MMA(1, 1, At, B1); PG8_BAR;
            }
        }
        if constexpr (ALIGN_EPI) { if (wr == 0) PG8_BAR; }
        if constexpr (!Epi::AFTER_DRAIN) { E(acc, cur, wr, wc, fr, fq); S.done(cur); }
        if (!has_next) break;
#pragma unroll
        for (int a = 0; a < 2; ++a)
#pragma unroll
            for (int b = 0; b < 2; ++b)
#pragma unroll
                for (int m = 0; m < 4; ++m)
#pragma unroll
                    for (int n = 0; n < 2; ++n) acc[a][b][m][n] = (f32x4){0.f, 0.f, 0.f, 0.f};
        cur = nxt; cA = nA; cB = nB; ++ui;
        if constexpr (ALIGN_EPI) { if (wr == 1) PG8_BAR; }
    }
    PG8_WAIT_V(0);
    if constexpr (!ALIGN_EPI) { if (wr == 0) PG8_BAR; }
    PG8_BAR;
    if constexpr (Epi::AFTER_DRAIN) { E.fused(acc, cur, wr, wc, fr, fq, lds, wid, lane); S.done(cur); }
#undef PG8_SA
#undef PG8_SB
#undef PG8_STAGE
#undef PG8_LDA
#undef PG8_LDB
#undef PG8_MMA
#undef PG8_WAIT_V
#undef PG8_WAIT_L
#undef PG8_BAR
#undef PG8_SCHED
}
}
constexpr int NWAVES = 8;
constexpr int BATCH = 8, SEQ = 4096, D = 1024, M = BATCH * SEQ;
constexpr int DFF = 2816, NGU = 2 * DFF, DRW = 512, DCV = 512, NH = 8, HS = 64;
constexpr int DSHIFT = 3 * DRW + 64 + 64 + 128;
constexpr int DIN = DSHIFT + 2 * DCV;
constexpr int CONVW = 31;
constexpr float RMS_EPS = 1e-6f, GN_EPS = 64e-5f, LN_EPS = 1e-5f, DECAY_SCALE = 0.60653065971f;
#ifndef MK_ONE_LAUNCH
#define MK_ONE_LAUNCH 1
#endif
constexpr int N_PHASES = 12;

constexpr size_t MiB = 1u << 20;
constexpr size_t WS_CTL = 0, CTL_ZERO_BYTES = 1 * MiB;
constexpr size_t WS_WGU1 = 2 * MiB, WS_WDN1 = 13 * MiB, WS_WIN = 19 * MiB, WS_WOUT = 25 * MiB, WS_WGU2 = 27 * MiB, WS_WDN2 = 38 * MiB;
constexpr size_t WS_XN = 48 * MiB;
constexpr size_t WS_H = 112 * MiB;
constexpr size_t WS_F = 288 * MiB;
constexpr size_t WS_OAB = 416 * MiB;
constexpr size_t WS_END = 480 * MiB;
static_assert(WS_WGU1 + (size_t)NGU * D * 2 <= WS_WDN1 && WS_WDN1 + (size_t)D * DFF * 2 <= WS_WIN && WS_WIN + (size_t)DIN * D * 2 <= WS_WOUT && WS_WOUT + (size_t)D * D * 2 <= WS_WGU2 &&
              WS_WGU2 + (size_t)NGU * D * 2 <= WS_WDN2 && WS_WDN2 + (size_t)D * DFF * 2 <= WS_XN && WS_XN + (size_t)M * D * 2 <= WS_H && WS_H + (size_t)M * DFF * 2 <= WS_F &&
              WS_F + (size_t)M * D * 4 <= WS_OAB && WS_OAB + (size_t)M * D * 2 <= WS_END, "d_ws map");
constexpr size_t WS_LORA = 44 * MiB;
constexpr size_t WS_MT = WS_XN, WS_NT = WS_XN + 32 * MiB, WS_RZ = WS_F, WS_Y0 = WS_F + 32 * MiB, WS_ET = WS_F + 64 * MiB, WS_GW = WS_F + 96 * MiB;
constexpr int NCH = SEQ / 64;
constexpr int CW_TMO = 0, CW_CODE = 1;
constexpr int CW_BAR = 4096;

constexpr int RING_OFF = 0, RING_BYTES = 147456;
constexpr int LDSCTL_OFF = RING_BYTES, MISC_OFF = LDSCTL_OFF + 320;
constexpr int LDS_BYTES = 148480;
static_assert(MISC_OFF + 128 <= LDS_BYTES, "LDS map");
#define GAS __attribute__((address_space(1)))
#define LAS __attribute__((address_space(3)))
typedef unsigned short bf16;
typedef unsigned v4u __attribute__((ext_vector_type(4)));
typedef float f32x4 __attribute__((ext_vector_type(4)));
typedef short bf16x8 __attribute__((ext_vector_type(8)));
typedef GAS unsigned gu32;
typedef GAS unsigned long long gu64;
#define RLX_AGENT __ATOMIC_RELAXED, __HIP_MEMORY_SCOPE_AGENT
#define LDS_WAIT() asm volatile("s_waitcnt lgkmcnt(0)" ::: "memory")
#define VM_WAIT() asm volatile("s_waitcnt vmcnt(0)" ::: "memory")
__device__ __forceinline__ unsigned long long rt() { return __builtin_amdgcn_s_memrealtime(); }
typedef __bf16 bf16x2_t __attribute__((ext_vector_type(2)));
__device__ __forceinline__ unsigned f2bf(float f) { return (unsigned)__builtin_bit_cast(unsigned short, (__bf16)f); }
__device__ __forceinline__ unsigned pk2(float lo, float hi) { bf16x2_t v; v.x = (__bf16)lo; v.y = (__bf16)hi; return __builtin_bit_cast(unsigned, v); }
#define XB_TMO      128
#define XB_XCNT(j)  (256  + 64 * (j))
#define XB_XSUB(j)  (1280 + 64 * (j))
#define XB_XGEN(j)  (2304 + 64 * (j))
#define XB_TOP      3328
#define XB_TOPGEN   3392
#define XCD_BAR_WORDS 3456
#define XB_SPIN_CAP (1u << 18)

__device__ __forceinline__ unsigned xb_ld(unsigned* p)              { return __hip_atomic_load(p, __ATOMIC_RELAXED, __HIP_MEMORY_SCOPE_AGENT); }
__device__ __forceinline__ unsigned xb_add(unsigned* p, unsigned v) { return __hip_atomic_fetch_add(p, v, __ATOMIC_RELAXED, __HIP_MEMORY_SCOPE_AGENT); }
__device__ __forceinline__ unsigned xb_xcc_id() { return (unsigned)__builtin_amdgcn_s_getreg((3 << 11) | 20) & 0xFu; }
#define XB_SPIN(cond, bar) do { unsigned _sp = 0; while (cond) { __builtin_amdgcn_s_sleep(1); \
    if ((++_sp & 255u) == 0u) { if (xb_ld(&(bar)[XB_TMO])) break; if (_sp > XB_SPIN_CAP) { atomicAdd(&(bar)[XB_TMO], 1u); break; } } } } while (0)

struct XcdBarrier {
    unsigned* bar; unsigned x;
    volatile LAS unsigned* st;
};

__device__ __forceinline__ XcdBarrier xcd_barrier_post(unsigned* bar, volatile LAS unsigned* st) {
    XcdBarrier b; b.bar = bar; b.x = xb_xcc_id(); b.st = st;
    if (threadIdx.x == 0) (void)xb_add(&bar[XB_XCNT(b.x)], 1u);
    return b;
}
__device__ __forceinline__ void xcd_barrier_complete(unsigned* bar, unsigned x, unsigned& nloc, unsigned& nx) {
    const unsigned G = gridDim.x * gridDim.y * gridDim.z;
    unsigned sum, cnt, mine, sp = 0u;
    for (;;) {
        sum = 0u; cnt = 0u; mine = 0u;
#pragma unroll
        for (unsigned j = 0; j < 16; ++j) { const unsigned c = xb_ld(&bar[XB_XCNT(j)]); sum += c; cnt += (c > 0u) ? 1u : 0u; mine = (j == x) ? c : mine; }
        if (sum == G) break;
        __builtin_amdgcn_s_sleep(1);
        if ((++sp & 255u) == 0u) { if (xb_ld(&bar[XB_TMO])) break; if (sp > XB_SPIN_CAP) { atomicAdd(&bar[XB_TMO], 1u); break; } }
    }
    nloc = mine > 0u ? mine : 1u; nx = cnt > 0u ? cnt : 1u;
}

__device__ __forceinline__ void xcd_barrier(const XcdBarrier& b) {
    asm volatile("s_waitcnt vmcnt(0)" ::: "memory");
    __syncthreads();
    if (threadIdx.x == 0) {
        unsigned* bar = b.bar;
        __builtin_amdgcn_s_waitcnt(0);
        unsigned nloc = b.st[0], nx = b.st[1];
        if (nloc == 0u) { xcd_barrier_complete(bar, b.x, nloc, nx); b.st[0] = nloc; b.st[1] = nx; }
        const unsigned old = xb_add(&bar[XB_XSUB(b.x)], 1u);
        const unsigned gen = old / nloc;
        if (old + 1u == (gen + 1u) * nloc) {
            __builtin_amdgcn_fence(__ATOMIC_RELEASE, "agent");
            asm volatile("s_waitcnt vmcnt(0)" ::: "memory");
            const unsigned og = xb_add(&bar[XB_TOP], 1u);
            const unsigned tg = og / nx;
            if (og + 1u == (tg + 1u) * nx) xb_add(&bar[XB_TOPGEN], 1u);
            else XB_SPIN(xb_ld(&bar[XB_TOPGEN]) == tg, bar);
            __builtin_amdgcn_fence(__ATOMIC_ACQUIRE, "agent");
            xb_add(&bar[XB_XGEN(b.x)], 1u);
            asm volatile("s_waitcnt vmcnt(0)" ::: "memory");
        } else {
            XB_SPIN(xb_ld(&bar[XB_XGEN(b.x)]) == gen, bar);
            __builtin_amdgcn_fence(__ATOMIC_ACQUIRE, "agent");
            asm volatile("s_waitcnt vmcnt(0)" ::: "memory");
        }
    }
    __syncthreads();
}
struct Frame {
    LAS unsigned char* lds;
    volatile LAS unsigned* MISC;
    gu32* ctl; unsigned char* ws;
    int tid, lane, wave;
    int vcu, G;
    const float* in[28]; float* out;
    bf16 *Wgu1, *Wdn1, *Win, *Wout, *Wgu2, *Wdn2;
    bf16 *XN, *H, *OAB; float* Fm;
};
enum { I_X = 0, I_F1PRE, I_F1POST, I_F1GU, I_F1DN, I_MPRE, I_MPOST, I_WIN, I_MU, I_WUP, I_W0, I_AUP, I_A0, I_GUP, I_KK, I_KA, I_RK, I_GNW, I_GNB, I_CDW, I_CB, I_CLW, I_CLB, I_WOUT, I_F2PRE, I_F2POST, I_F2GU, I_F2DN };

__device__ __forceinline__ float wave_sum(float v) {
#pragma unroll
    for (int o = 1; o < 64; o <<= 1) v += __shfl_xor(v, o);
    return v;
}
__device__ __forceinline__ float bf2f(bf16 v) { return __uint_as_float(((unsigned)v) << 16); }
__device__ __forceinline__ float sigm(float x) { return 1.0f / (1.0f + __expf(-x)); }

__device__ __forceinline__ void p0_transpose_item(const float* W, int K, int N, bf16* WT, int gu, LAS float* scr, int item, int lane) {
    const int nblk = N / 32, kb = item / nblk, nb = item % nblk, k0 = 64 * kb, n0 = 32 * nb;
    int r0 = n0;
    if (gu) { const int up = n0 >= DFF ? 1 : 0, nn = n0 - up * DFF; r0 = (nn >> 7) * 256 + up * 128 + (nn & 127); }
#pragma unroll 8
    for (int i = 0; i < 32; ++i) { const int kk = 2 * i + (lane >> 5); scr[kk * 33 + (lane & 31)] = W[(size_t)(k0 + kk) * N + n0 + (lane & 31)]; }
    LDS_WAIT(); asm volatile("" ::: "memory");
    const int c = lane & 7;
#pragma unroll
    for (int j = 0; j < 4; ++j) { const int n = (lane >> 3) + 8 * j; const LAS float* s = scr + (8 * c) * 33 + n;
        v4u o; o.x = pk2(s[0 * 33], s[1 * 33]); o.y = pk2(s[2 * 33], s[3 * 33]); o.z = pk2(s[4 * 33], s[5 * 33]); o.w = pk2(s[6 * 33], s[7 * 33]);
        *(GAS v4u*)(WT + (size_t)(r0 + n) * K + k0 + 8 * c) = o; }
    LDS_WAIT(); asm volatile("" ::: "memory");
}
__device__ __forceinline__ void rms_row_to_bf16(Frame& F, const float* xrow, const float* g, bf16* orow) {
    const GAS f32x4* xr = (const GAS f32x4*)xrow + F.lane; const GAS f32x4* gr = (const GAS f32x4*)g + F.lane;
    f32x4 v[4]; float s = 0.f;
#pragma unroll
    for (int j = 0; j < 4; ++j) { v[j] = xr[64 * j]; s += (v[j].x * v[j].x + v[j].y * v[j].y) + (v[j].z * v[j].z + v[j].w * v[j].w); }
    const float r = 1.0f / sqrtf(wave_sum(s) * (1.f / D) + RMS_EPS);
    GAS unsigned long long* o8 = (GAS unsigned long long*)orow + F.lane;
#pragma unroll
    for (int j = 0; j < 4; ++j) { const f32x4 gg = gr[64 * j]; o8[64 * j] = (unsigned long long)pk2(v[j].x * r * gg.x, v[j].y * r * gg.y) | ((unsigned long long)pk2(v[j].z * r * gg.z, v[j].w * r * gg.w) << 32); }
}
__device__ __forceinline__ void p0_prologue(Frame& F) {
    LAS float* scr = (LAS float*)(F.lds + RING_OFF + F.wave * 16384);
    const int gw = F.vcu * NWAVES + F.wave, NGW = F.G * NWAVES;
    constexpr int I_GU = (D / 64) * (NGU / 32), I_DN = (DFF / 64) * (D / 32), I_IN = (D / 64) * (DIN / 32), I_OUT = (D / 64) * (D / 32);
    constexpr int NITEMS = 2 * I_GU + 2 * I_DN + I_IN + I_OUT + 16 + 16 + 32;
    for (int it = gw; it < NITEMS; it += NGW) {
        int r = it;
        if (r < I_GU) { p0_transpose_item(F.in[I_F1GU], D, NGU, F.Wgu1, 1, scr, r, F.lane); continue; } r -= I_GU;
        if (r < I_GU) { p0_transpose_item(F.in[I_F2GU], D, NGU, F.Wgu2, 1, scr, r, F.lane); continue; } r -= I_GU;
        if (r < I_DN) { p0_transpose_item(F.in[I_F1DN], DFF, D, F.Wdn1, 0, scr, r, F.lane); continue; } r -= I_DN;
        if (r < I_DN) { p0_transpose_item(F.in[I_F2DN], DFF, D, F.Wdn2, 0, scr, r, F.lane); continue; } r -= I_DN;
        if (r < I_IN) { p0_transpose_item(F.in[I_WIN], D, DIN, F.Win, 0, scr, r, F.lane); continue; } r -= I_IN;
        if (r < I_OUT) { p0_transpose_item(F.in[I_WOUT], D, D, F.Wout, 0, scr, r, F.lane); continue; } r -= I_OUT;
        bf16* lora = (bf16*)(F.ws + WS_LORA);
        if (r < 16) { p0_transpose_item(F.in[I_WUP], 64, DRW, lora, 0, scr, r, F.lane); continue; } r -= 16;
        if (r < 16) { p0_transpose_item(F.in[I_AUP], 64, DRW, lora + 512 * 64, 0, scr, r, F.lane); continue; } r -= 16;
        p0_transpose_item(F.in[I_GUP], 128, DRW, lora + 2 * 512 * 64, 0, scr, r, F.lane);
    }
    for (int m = gw; m < M; m += NGW) rms_row_to_bf16(F, F.in[I_X] + (size_t)m * D, F.in[I_F1PRE], F.XN + (size_t)m * D);
}
__device__ __forceinline__ void norm_pass(Frame& F, const float* Fm, const float* base, float* out, const float* gpost, float scale, const float* gpre, bf16* xn) {
    const int gw = F.vcu * NWAVES + F.wave, NGW = F.G * NWAVES;
    for (int m = gw; m < M; m += NGW) {
        const GAS f32x4* fr = (const GAS f32x4*)(Fm + (size_t)m * D) + F.lane; const GAS f32x4* br = (const GAS f32x4*)(base + (size_t)m * D) + F.lane;
        const GAS f32x4* gp = (const GAS f32x4*)gpost + F.lane;
        f32x4 f[4], o[4]; float s = 0.f;
#pragma unroll
        for (int j = 0; j < 4; ++j) { f[j] = fr[64 * j]; o[j] = br[64 * j]; s += (f[j].x * f[j].x + f[j].y * f[j].y) + (f[j].z * f[j].z + f[j].w * f[j].w); }
        const float r = scale / sqrtf(wave_sum(s) * (1.f / D) + RMS_EPS);
        float s2 = 0.f;
#pragma unroll
        for (int j = 0; j < 4; ++j) { const f32x4 g = gp[64 * j]; o[j] = o[j] + f[j] * r * g; s2 += (o[j].x * o[j].x + o[j].y * o[j].y) + (o[j].z * o[j].z + o[j].w * o[j].w); }
        GAS f32x4* orow = (GAS f32x4*)(out + (size_t)m * D) + F.lane;
#pragma unroll
        for (int j = 0; j < 4; ++j) orow[64 * j] = o[j];
        if (xn) {
            const float r2 = 1.0f / sqrtf(wave_sum(s2) * (1.f / D) + RMS_EPS);
            const GAS f32x4* gq = (const GAS f32x4*)gpre + F.lane;
            GAS unsigned long long* o8 = (GAS unsigned long long*)(xn + (size_t)m * D) + F.lane;
#pragma unroll
            for (int j = 0; j < 4; ++j) { const f32x4 gg = gq[64 * j]; o8[64 * j] = (unsigned long long)pk2(o[j].x * r2 * gg.x, o[j].y * r2 * gg.y) | ((unsigned long long)pk2(o[j].z * r2 * gg.z, o[j].w * r2 * gg.w) << 32); }
        }
    }
}

struct ConvW { float w[CONVW]; float cb, lw, lb; };
__device__ __forceinline__ void conv_load_w(Frame& F, ConvW& W) {
    const int c = F.tid;
#pragma unroll
    for (int j = 0; j < CONVW; ++j) W.w[j] = F.in[I_CDW][j * DCV + c];
    W.cb = F.in[I_CB][c]; W.lw = F.in[I_CLW][c]; W.lb = F.in[I_CLB][c];
}
__device__ __forceinline__ void conv_unit(Frame& F, const bf16* P, int unit, const ConvW& W) {
    const int b = unit / (SEQ / 32), t0 = (unit % (SEQ / 32)) * 32, c = F.tid;
    LAS float* sG = (LAS float*)(F.lds + RING_OFF);
    LAS float* sRed = sG + 62 * 512;
    const bf16* pb = P + (size_t)b * SEQ * DIN + DSHIFT + c;
#pragma unroll
    for (int half = 0; half < 2; ++half) {
        unsigned short va[31], vg[31];
#pragma unroll
        for (int k = 0; k < 31; ++k) { const int t = t0 - 30 + 31 * half + k; const bf16* pr = pb + (size_t)(t < 0 ? 0 : t) * DIN; va[k] = pr[0]; vg[k] = pr[DCV]; }
#pragma unroll
        for (int k = 0; k < 31; ++k) { const int t = t0 - 30 + 31 * half + k; const float v = bf2f(va[k]) * sigm(bf2f(vg[k])); sG[(31 * half + k) * 512 + c] = (t >= 0) ? v : 0.f; }
    }
#pragma unroll 1
    for (int tt = 0; tt < 32; ++tt) { float a = W.cb;
#pragma unroll
        for (int j = 0; j < CONVW; ++j) a += W.w[j] * sG[(tt + j) * 512 + c];
        sG[tt * 512 + c] = a;
        const float s = wave_sum(a); if (F.lane == 0) sRed[tt * 8 + F.wave] = s; }
    __syncthreads();
#pragma unroll 1
    for (int tt = 0; tt < 32; ++tt) { float s = 0.f;
#pragma unroll
        for (int k = 0; k < 8; ++k) s += sRed[tt * 8 + k];
        sG[tt * 512 + c] -= s * (1.f / DCV); }
    __syncthreads();
#pragma unroll 1
    for (int tt = 0; tt < 32; ++tt) { const float d = sG[tt * 512 + c]; const float s = wave_sum(d * d); if (F.lane == 0) sRed[tt * 8 + F.wave] = s; }
    __syncthreads();
#pragma unroll 1
    for (int tt = 0; tt < 32; ++tt) { float s = 0.f;
#pragma unroll
        for (int k = 0; k < 8; ++k) s += sRed[tt * 8 + k];
        const float v = sG[tt * 512 + c] * (1.0f / sqrtf(s * (1.f / DCV) + LN_EPS)) * W.lw + W.lb;
        F.OAB[(size_t)(b * SEQ + t0 + tt) * D + DRW + c] = (bf16)f2bf(v * sigm(v)); }
    __syncthreads();
}

constexpr int LS = 72;
constexpr int SLOT = 64 * LS * 2;
constexpr int O_RT = 0, O_ZT = SLOT, O_BT = 2 * SLOT, O_KT = 3 * SLOT, O_ZTT = 4 * SLOT, O_VT = 5 * SLOT, O_BHT = 6 * SLOT, O_KHT = 7 * SLOT;
constexpr int O_X1T = O_ZT, O_U0T = O_BT, O_WZT = O_KT;
constexpr int O_LZK = 8 * SLOT, O_LRB = 9 * SLOT, O_LRK = 10 * SLOT, O_TL = 11 * SLOT;
constexpr int LTS = 68;
constexpr int O_LT = 12 * SLOT;
constexpr int SS = 40;
constexpr int O_L10 = O_LT + 64 * LTS * 4, O_T00T = O_L10 + 32 * SS * 2, O_XT = O_T00T + 64 * SS * 2, O_PC = O_XT + 32 * SS * 2, O_TOT = O_PC + 256, O_AEND = O_TOT + 2048;
constexpr int O_LDF = 0, O_AAF = 64 * 65 * 4, O_GGF = 2 * 64 * 65 * 4;
constexpr int O_TX = 8 * SLOT, O_XA = 9 * SLOT, O_SG = 10 * SLOT;
constexpr int SGS = 136;
static_assert(O_GGF + 64 * 65 * 4 <= 8 * SLOT && O_SG + 64 * SGS * 2 <= O_LT && O_AEND <= RING_BYTES, "rwkv LDS map");

typedef float f32x4v __attribute__((ext_vector_type(4)));
__device__ __forceinline__ f32x4 mfma16(bf16x8 a, bf16x8 b, f32x4 c) { return __builtin_amdgcn_mfma_f32_16x16x32_bf16(a, b, c, 0, 0, 0); }
__device__ __forceinline__ f32x4 mm16(const LAS bf16* A, int lda, const LAS bf16* B, int ldb, int tm, int tn, int nks, int lane, f32x4 acc) {
    const LAS bf16* ap = A + (16 * tm + (lane & 15)) * lda + 8 * (lane >> 4);
    const LAS bf16* bp = B + (16 * tn + (lane & 15)) * ldb + 8 * (lane >> 4);
#pragma unroll
    for (int ks = 0; ks < 2; ++ks) if (ks < nks) acc = mfma16(*(const LAS bf16x8*)(ap + 32 * ks), *(const LAS bf16x8*)(bp + 32 * ks), acc);
    return acc;
}
typedef unsigned u32x2 __attribute__((ext_vector_type(2)));
__device__ __forceinline__ u32x2 pack4(f32x4 v) { u32x2 r; r.x = pk2(v[0], v[1]); r.y = pk2(v[2], v[3]); return r; }
__device__ __forceinline__ void wr_nat(LAS bf16* W, int ldw, int tm, int tn, int lane, f32x4 v) { *(LAS u32x2*)(W + (16 * tn + (lane & 15)) * ldw + 16 * tm + 4 * (lane >> 4)) = pack4(v); }
__device__ __forceinline__ float sigm_fast(float x) { return __builtin_amdgcn_rcpf(1.0f + __builtin_amdgcn_exp2f(x * -1.44269504f)); }
__device__ __forceinline__ float fast_tanh(float x) { const float e = __builtin_amdgcn_exp2f(x * 2.88539008f); return 1.0f - 2.0f * __builtin_amdgcn_rcpf(e + 1.0f); }
#define WG_BAR() do { asm volatile("s_waitcnt lgkmcnt(0)" ::: "memory"); __builtin_amdgcn_s_barrier(); asm volatile("" ::: "memory"); } while (0)

#ifndef INV_PF_MAX
#define INV_PF_MAX 5
#endif
template <int S> struct InvStep {
    static constexpr int T0 = ((S + 1) >> 2) << 2, N4 = (32 - T0) / 4;
    static __device__ __forceinline__ void load(f32x4 (&v)[8], const LAS float* Lb) {
#pragma unroll
        for (int k = 0; k < N4; ++k) v[k] = *(const LAS f32x4*)(Lb + S * LTS + T0 + 4 * k);
    }
    static __device__ __forceinline__ void run(float (&x)[32], const LAS float* Lb, const f32x4 (&cur)[8]) {
        f32x4 nxt[8];
        InvStep<S + 1>::load(nxt, Lb);
        asm volatile("" ::: "memory");
        const float xs = x[S];
#pragma unroll
        for (int k = 0; k < N4; ++k)
#pragma unroll
            for (int r = 0; r < 4; ++r) if (T0 + 4 * k + r > S) asm volatile("v_fmac_f32 %0, %1, %2" : "+v"(x[T0 + 4 * k + r]) : "v"(cur[k][r]), "v"(xs));
        InvStep<S + 1>::run(x, Lb, nxt);
    }
};
template <> struct InvStep<31> { static __device__ __forceinline__ void load(f32x4 (&)[8], const LAS float*) {} static __device__ __forceinline__ void run(float (&)[32], const LAS float*, const f32x4 (&)[8]) {} };
#define LAUNDER_IDX() int lane = lane0, w = w0; asm volatile("" : "+v"(lane)); asm volatile("" : "+s"(w)); const int q4 = lane >> 4, l15 = lane & 15; (void)q4; (void)l15
__device__ __forceinline__ float row16_sum(float v) {
    v += __builtin_bit_cast(float, __builtin_amdgcn_update_dpp(0, __builtin_bit_cast(int, v), 0xB1, 0xF, 0xF, true));
    v += __builtin_bit_cast(float, __builtin_amdgcn_update_dpp(0, __builtin_bit_cast(int, v), 0x4E, 0xF, 0xF, true));
    v += __builtin_bit_cast(float, __builtin_amdgcn_update_dpp(0, __builtin_bit_cast(int, v), 0x141, 0xF, 0xF, true));
    v += __builtin_bit_cast(float, __builtin_amdgcn_update_dpp(0, __builtin_bit_cast(int, v), 0x140, 0xF, 0xF, true));
    return v;
}
__device__ __forceinline__ float wave_sum_dpp(float v) {
    v = row16_sum(v);
    const int iv = __builtin_bit_cast(int, v);
    const float a = __builtin_bit_cast(float, __builtin_amdgcn_readlane(iv, 0)), b = __builtin_bit_cast(float, __builtin_amdgcn_readlane(iv, 16));
    const float c = __builtin_bit_cast(float, __builtin_amdgcn_readlane(iv, 32)), d = __builtin_bit_cast(float, __builtin_amdgcn_readlane(iv, 48));
    return (a + b) + (c + d);
}
#ifndef PROBE_STAGE
#define PROBE_STAGE -1
#endif
#define SREP(k) for (int srep_ = 0; srep_ < ((PROBE_STAGE) == (k) ? 3 : 1); ++srep_)
struct PrepRaw { unsigned v[3][9]; float mu[3]; bf16x8 fWu[2][2], fAu[2][2], fGu[2][4]; float cW0[2], cA0[2], cKK, cKA, cRK, cGW, cGB; };
struct PairRaw { unsigned v[4][9]; float mu[4]; };
struct PairFrag { bf16x8 tx[2], xa[2], sg[4]; };
__device__ __forceinline__ void rwkv_unit_issue(Frame& F, const bf16* P, int b, int c, int h, PrepRaw& R) {
    const int lane0 = F.lane, w0 = F.wave; LAUNDER_IDX();
    const size_t row0 = (size_t)b * SEQ + c * 64 + 8 * w;
    const long poff = (c * 64 + 8 * w > 0) ? -(long)DIN : 0;
#pragma unroll
    for (int g = 0; g < 3; ++g) { const int col = g * DRW + h * 64 + lane; const bf16* pc = P + row0 * DIN + col;
        R.mu[g] = F.in[I_MU][col];
        R.v[g][0] = pc[poff];
#pragma unroll
        for (int i = 0; i < 8; ++i) R.v[g][i + 1] = pc[(size_t)i * DIN]; }
    const bf16* WupT = (const bf16*)(F.ws + WS_LORA); const bf16* AupT = WupT + 512 * 64; const bf16* GupT = AupT + 512 * 64;
#pragma unroll
    for (int tt = 0; tt < 2; ++tt) { const int gj = h * 64 + 16 * (2 * (w & 1) + tt) + l15;
        const bf16* wu = WupT + (size_t)gj * 64 + 8 * q4; const bf16* au = AupT + (size_t)gj * 64 + 8 * q4; const bf16* gu = GupT + (size_t)gj * 128 + 8 * q4;
#pragma unroll
        for (int ks = 0; ks < 2; ++ks) { R.fWu[tt][ks] = *(const GAS bf16x8*)(wu + 32 * ks); R.fAu[tt][ks] = *(const GAS bf16x8*)(au + 32 * ks); }
#pragma unroll
        for (int ks = 0; ks < 4; ++ks) R.fGu[tt][ks] = *(const GAS bf16x8*)(gu + 32 * ks);
        R.cW0[tt] = F.in[I_W0][gj]; R.cA0[tt] = F.in[I_A0][gj]; }
    const int hj = h * 64 + lane;
    R.cKK = F.in[I_KK][hj]; R.cKA = F.in[I_KA][hj]; R.cRK = F.in[I_RK][hj]; R.cGW = F.in[I_GNW][hj]; R.cGB = F.in[I_GNB][hj];
}
__device__ __forceinline__ void rwkv_pair_issue(Frame& F, const bf16* P, int b, int c, PairRaw& R) {
    const int lane0 = F.lane, w0 = F.wave; LAUNDER_IDX();
    const size_t row0 = (size_t)b * SEQ + c * 64 + 8 * w;
    const long poff = (c * 64 + 8 * w > 0) ? -(long)DIN : 0;
#pragma unroll
    for (int g = 0; g < 4; ++g) { const int col = 3 * DRW + 64 * g + lane; const bf16* pc = P + row0 * DIN + col;
        R.mu[g] = F.in[I_MU][col];
        R.v[g][0] = pc[poff];
#pragma unroll
        for (int i = 0; i < 8; ++i) R.v[g][i + 1] = pc[(size_t)i * DIN]; }
}
__device__ __forceinline__ void rwkv_pair_prologue(Frame& F, int c, const PairRaw& R, PairFrag& A) {
    const int lane0 = F.lane, w0 = F.wave; LAUNDER_IDX();
    LAS unsigned char* L = F.lds + RING_OFF;
    LAS bf16* TX = (LAS bf16*)(L + O_TX); LAS bf16* XA = (LAS bf16*)(L + O_XA); LAS bf16* SG = (LAS bf16*)(L + O_SG);
    const bool hasprev = (c * 64 + 8 * w) > 0;
#pragma unroll
    for (int g = 0; g < 4; ++g) { const float mu = R.mu[g]; float prev = hasprev ? __uint_as_float(R.v[g][0] << 16) : 0.f;
#pragma unroll
        for (int i = 0; i < 8; ++i) { const float cur = __uint_as_float(R.v[g][i + 1] << 16); const float v = cur + (prev - cur) * mu; prev = cur;
            if (g == 0) TX[(8 * w + i) * LS + lane] = (bf16)f2bf(fast_tanh(v));
            else if (g == 1) XA[(8 * w + i) * LS + lane] = (bf16)f2bf(v);
            else SG[(8 * w + i) * SGS + (g - 2) * 64 + lane] = (bf16)f2bf(sigm_fast(v)); } }
    WG_BAR();
    const int tm = w >> 1;
    const LAS bf16* txp = TX + (16 * tm + l15) * LS + 8 * q4; const LAS bf16* xap = XA + (16 * tm + l15) * LS + 8 * q4; const LAS bf16* sgp = SG + (16 * tm + l15) * SGS + 8 * q4;
#pragma unroll
    for (int ks = 0; ks < 2; ++ks) { A.tx[ks] = *(const LAS bf16x8*)(txp + 32 * ks); A.xa[ks] = *(const LAS bf16x8*)(xap + 32 * ks); }
#pragma unroll
    for (int ks = 0; ks < 4; ++ks) A.sg[ks] = *(const LAS bf16x8*)(sgp + 32 * ks);
    asm volatile("s_waitcnt lgkmcnt(0)" ::: "memory");
}
__device__ __forceinline__ void rwkv_prep_unit(Frame& F, const bf16* P, int b, int c, int h, const PairFrag& A, PrepRaw& R, int nb, int nc, int nh, PairRaw& RX, int np_b, int np_c) {
    const int lane0 = F.lane, w0 = F.wave;
    LAS unsigned char* L = F.lds + RING_OFF;
    LAS bf16* Rt = (LAS bf16*)(L + O_RT); LAS bf16* Zt = (LAS bf16*)(L + O_ZT); LAS bf16* Bt = (LAS bf16*)(L + O_BT); LAS bf16* Kt = (LAS bf16*)(L + O_KT);
    LAS bf16* ZtT = (LAS bf16*)(L + O_ZTT); LAS bf16* VT = (LAS bf16*)(L + O_VT); LAS bf16* BhT = (LAS bf16*)(L + O_BHT); LAS bf16* KhT = (LAS bf16*)(L + O_KHT);
    LAS bf16* U0T = (LAS bf16*)(L + O_U0T); LAS bf16* X1T = (LAS bf16*)(L + O_X1T); LAS bf16* WzT = (LAS bf16*)(L + O_WZT);
    LAS bf16* Lzk = (LAS bf16*)(L + O_LZK); LAS bf16* Lrb = (LAS bf16*)(L + O_LRB); LAS bf16* Lrk = (LAS bf16*)(L + O_LRK); LAS bf16* Tl = (LAS bf16*)(L + O_TL);
    LAS float* LT = (LAS float*)(L + O_LT); LAS bf16* L10 = (LAS bf16*)(L + O_L10); LAS bf16* T00T = (LAS bf16*)(L + O_T00T); LAS bf16* XT = (LAS bf16*)(L + O_XT);
    LAS float* PCv = (LAS float*)(L + O_PC); LAS float* TOT = (LAS float*)(L + O_TOT);
    LAS float* LDf = (LAS float*)(L + O_LDF); LAS float* AAf = (LAS float*)(L + O_AAF); LAS float* GGf = (LAS float*)(L + O_GGF);
    unsigned char* ws = F.ws;
    const bf16* WupT = (const bf16*)(ws + WS_LORA); const bf16* AupT = WupT + 512 * 64; const bf16* GupT = AupT + 512 * 64;
    const int unit = (b * NH + h) * NCH + c;
    bf16* MTg = (bf16*)(ws + WS_MT) + (size_t)unit * 4096; bf16* NTg = (bf16*)(ws + WS_NT) + (size_t)unit * 4096;
    bf16* RZg = (bf16*)(ws + WS_RZ) + (size_t)unit * 4096; bf16* Y0g = (bf16*)(ws + WS_Y0) + (size_t)unit * 4096;
    bf16* ETg = (bf16*)(ws + WS_ET) + (size_t)unit * 4096; bf16* GWg = (bf16*)(ws + WS_GW) + (size_t)unit * 4096;
    const int tl0 = c * 64;
    const f32x4 z4 = {0.f, 0.f, 0.f, 0.f};

    const float cKK = R.cKK, cKA = R.cKA, cRK = R.cRK, cGW = R.cGW, cGB = R.cGB;
    SREP(1) {
    {
        LAUNDER_IDX();
        const int tm = w >> 1;
#pragma unroll
        for (int tt = 0; tt < 2; ++tt) { const int j = 16 * (2 * (w & 1) + tt) + l15;
            f32x4 aD = z4, aA = z4, aG = z4;
#pragma unroll
            for (int ks = 0; ks < 2; ++ks) { aD = mfma16(A.tx[ks], R.fWu[tt][ks], aD); aA = mfma16(A.xa[ks], R.fAu[tt][ks], aA); }
#pragma unroll
            for (int ks = 0; ks < 4; ++ks) aG = mfma16(A.sg[ks], R.fGu[tt][ks], aG);
#pragma unroll
            for (int r = 0; r < 4; ++r) { const int t = 16 * tm + 4 * q4 + r;
                LDf[t * 65 + j] = -DECAY_SCALE * sigm_fast(aD[r] + R.cW0[tt]); AAf[t * 65 + j] = sigm_fast(aA[r] + R.cA0[tt]); GGf[t * 65 + j] = aG[r]; }
        }
    }
    float rr[8], kx[8], vv[8];
    {
        LAUNDER_IDX();
        const bool hasprev = (tl0 + 8 * w) > 0;
#pragma unroll
        for (int g = 0; g < 3; ++g) { const float mu = R.mu[g]; float prev = hasprev ? __uint_as_float(R.v[g][0] << 16) : 0.f;
#pragma unroll
            for (int i = 0; i < 8; ++i) { const float cur = __uint_as_float(R.v[g][i + 1] << 16); const float v = cur + (prev - cur) * mu; prev = cur;
                if (g == 0) rr[i] = v; else if (g == 1) kx[i] = v; else vv[i] = v; } }
    }
    WG_BAR();
    {
        LAUNDER_IDX();
        float ld[8], aa[8], cl[8], gg[8];
#pragma unroll
        for (int i = 0; i < 8; ++i) { ld[i] = LDf[(8 * w + i) * 65 + lane]; aa[i] = AAf[(8 * w + i) * 65 + lane]; gg[i] = GGf[(8 * w + i) * 65 + lane]; }
        cl[0] = ld[0];
#pragma unroll
        for (int i = 1; i < 8; ++i) cl[i] = cl[i - 1] + ld[i];
        TOT[w * 64 + lane] = cl[7];
        float kn[8], kp[8], ev[8];
#pragma unroll
        for (int i = 0; i < 8; ++i) { const float kr = kx[i] * cKK; const float ss = wave_sum_dpp(kr * kr); kn[i] = kr * __builtin_amdgcn_rsqf(fmaxf(ss, 1e-12f));
            kp[i] = kx[i] * (1.0f + (aa[i] - 1.0f) * cKA);
            const float bon = wave_sum_dpp(rr[i] * kp[i] * cRK); ev[i] = (cGB + bon * vv[i]) * gg[i]; gg[i] *= cGW; }
        { v4u o;
          o.x = pk2(ev[0], ev[1]); o.y = pk2(ev[2], ev[3]); o.z = pk2(ev[4], ev[5]); o.w = pk2(ev[6], ev[7]); *(GAS v4u*)(ETg + lane * 64 + 8 * w) = o;
          o.x = pk2(gg[0], gg[1]); o.y = pk2(gg[2], gg[3]); o.z = pk2(gg[4], gg[5]); o.w = pk2(gg[6], gg[7]); *(GAS v4u*)(GWg + lane * 64 + 8 * w) = o; }
        WG_BAR();
        float off = 0.f, tot = 0.f;
#pragma unroll
        for (int k = 0; k < 8; ++k) { const float tv = TOT[k * 64 + lane]; tot += tv; if (k < w) off += tv; }
        float zt[8], bh[8], kh[8];
#pragma unroll
        for (int i = 0; i < 8; ++i) { const float cli = cl[i] + off; const float eL = __expf(cli), eLm = __expf(cli - ld[i]), ieL = __expf(-cli), eC = __expf(tot - cli);
            const float ka = kn[i] * aa[i]; const int t = 8 * w + i;
            zt[i] = -kn[i] * eLm; bh[i] = ka * eC; kh[i] = kp[i] * eC;
            Rt[t * LS + lane] = (bf16)f2bf(rr[i] * eL); Zt[t * LS + lane] = (bf16)f2bf(zt[i]); Bt[t * LS + lane] = (bf16)f2bf(ka * ieL); Kt[t * LS + lane] = (bf16)f2bf(kp[i] * ieL); }
        v4u o;
        o.x = pk2(zt[0], zt[1]); o.y = pk2(zt[2], zt[3]); o.z = pk2(zt[4], zt[5]); o.w = pk2(zt[6], zt[7]); *(LAS v4u*)(ZtT + lane * LS + 8 * w) = o;
        o.x = pk2(vv[0], vv[1]); o.y = pk2(vv[2], vv[3]); o.z = pk2(vv[4], vv[5]); o.w = pk2(vv[6], vv[7]); *(LAS v4u*)(VT + lane * LS + 8 * w) = o;
        o.x = pk2(bh[0], bh[1]); o.y = pk2(bh[2], bh[3]); o.z = pk2(bh[4], bh[5]); o.w = pk2(bh[6], bh[7]); *(LAS v4u*)(BhT + lane * LS + 8 * w) = o;
        o.x = pk2(kh[0], kh[1]); o.y = pk2(kh[2], kh[3]); o.z = pk2(kh[4], kh[5]); o.w = pk2(kh[6], kh[7]); *(LAS v4u*)(KhT + lane * LS + 8 * w) = o;
        if (w == 0) PCv[lane] = __expf(tot);
    }
    WG_BAR();
    }
    SREP(3) {
        LAUNDER_IDX();
        const int tm = w & 3;
        if (w < 4) {
#pragma unroll
            for (int tn = 0; tn < 4; ++tn) {
                const bool diag = (tn >> 1) == (tm >> 1) && tn <= tm, low = tm >= 2 && tn < 2;
                if (diag || low) {
                    f32x4 a = mm16(Zt, LS, Bt, LS, tm, tn, 2, lane, z4);
                    const int s = 16 * tn + l15, t0 = 16 * tm + 4 * q4;
                    if (diag) {
#pragma unroll
                        for (int r = 0; r < 4; ++r) a[r] = (t0 + r > s) ? a[r] : 0.f;
                        *(LAS f32x4*)(LT + s * LTS + t0) = a;
                    } else {
#pragma unroll
                        for (int r = 0; r < 4; ++r) L10[(t0 + r - 32) * SS + s] = (bf16)f2bf(a[r]); }
                }
            }
        } else {
#pragma unroll
            for (int tn = 0; tn < 4; ++tn) {
                f32x4 a = z4;
                if (tn >= tm) { a = mm16(Kt, LS, Zt, LS, tm, tn, 2, lane, z4);
                    const int t = 16 * tn + l15, s0 = 16 * tm + 4 * q4;
#pragma unroll
                    for (int r = 0; r < 4; ++r) a[r] = (t > s0 + r) ? a[r] : 0.f; }
                wr_nat(Lzk, LS, tm, tn, lane, a);
            }
        }
    }
    WG_BAR();
    SREP(4) {
    LAUNDER_IDX();
    if (w == 0) {
        const int blk = lane >> 5, cc = lane & 31;
        const LAS float* Lb = LT + (32 * blk) * LTS + 32 * blk;
        float x[32];
#pragma unroll
        for (int t = 0; t < 32; ++t) x[t] = (t == cc) ? 1.f : 0.f;
        { f32x4 l0[8]; InvStep<0>::load(l0, Lb); InvStep<0>::run(x, Lb, l0); }
#pragma unroll
        for (int t = 0; t < 32; ++t) Tl[(32 * blk + t) * LS + 32 * blk + cc] = (bf16)f2bf(x[t]);
#pragma unroll
        for (int g = 0; g < 4; ++g) { v4u o; o.x = pk2(x[8 * g], x[8 * g + 1]); o.y = pk2(x[8 * g + 2], x[8 * g + 3]); o.z = pk2(x[8 * g + 4], x[8 * g + 5]); o.w = pk2(x[8 * g + 6], x[8 * g + 7]);
            *(LAS v4u*)(T00T + lane * SS + 8 * g) = o; }
    } else if (w == 1) {
        const int t = lane >> 1, hf = lane & 1; const v4u z = {0u, 0u, 0u, 0u};
        *(LAS v4u*)(Tl + t * LS + 32 + 16 * hf) = z; *(LAS v4u*)(Tl + t * LS + 32 + 16 * hf + 8) = z;
    } else {
#pragma unroll 1
        for (int jb = w - 2; jb < 12; jb += 6) { const int p = jb >> 2, tm = jb & 3;
            if (p == 0) {
#pragma unroll
                for (int tn = 0; tn < 4; ++tn) wr_nat(X1T, LS, tm, tn, lane, mm16(Lzk, LS, VT, LS, tm, tn, 2, lane, z4));
            } else {
                const LAS bf16* Aop = (p == 1) ? Bt : Kt; LAS bf16* W = (p == 1) ? Lrb : Lrk;
#pragma unroll
                for (int tn = 0; tn < 4; ++tn) { f32x4 a = mm16(Aop, LS, Rt, LS, tm, tn, 2, lane, z4);
                    const int t = 16 * tn + l15, s0 = 16 * tm + 4 * q4;
#pragma unroll
                    for (int r = 0; r < 4; ++r) a[r] = (t >= s0 + r) ? a[r] : 0.f;
                    wr_nat(W, LS, tm, tn, lane, a); }
            }
        }
    }
    }
    WG_BAR();
    rwkv_unit_issue(F, P, nb, nc, nh, R);
    if (np_b >= 0) rwkv_pair_issue(F, P, np_b, np_c, RX);
    { LAUNDER_IDX();
    if (w < 4) { const int tm = w >> 1, tn = w & 1;
        wr_nat(XT, SS, tm, tn, lane, mm16(L10, SS, T00T, SS, tm, tn, 1, lane, z4)); } }
    WG_BAR();
    { LAUNDER_IDX();
    if (w < 4) { const int tm = w >> 1, tn = w & 1;
        const f32x4 a = mm16(XT, SS, Tl + 32 * LS + 32, LS, tm, tn, 1, lane, z4);
        *(LAS u32x2*)(Tl + (32 + 16 * tn + l15) * LS + 16 * tm + 4 * q4) = pack4(a); } }
    WG_BAR();
    SREP(7) { LAUNDER_IDX();
      const int tm = w & 3; const LAS bf16* Bop = (w < 4) ? ZtT : X1T; LAS bf16* W = (w < 4) ? WzT : U0T;
#pragma unroll
      for (int tn = 0; tn < 4; ++tn) wr_nat(W, LS, tm, tn, lane, mm16(Tl, LS, Bop, LS, tm, tn, 2, lane, z4)); }
    WG_BAR();
    SREP(8) { LAUNDER_IDX();
      const int p = w >> 1;
#pragma unroll
      for (int k = 0; k < 8; ++k) { const int tm = 2 * (w & 1) + (k >> 2), tn = k & 3;
        const int n = 16 * tn + l15, m0 = 16 * tm + 4 * q4; f32x4 a; bf16* dst;
        if (p == 0) { a = mm16(WzT, LS, BhT, LS, tm, tn, 2, lane, z4);
            const float pc = PCv[n];
#pragma unroll
            for (int r = 0; r < 4; ++r) if (m0 + r == n) a[r] += pc;
            dst = MTg; }
        else if (p == 1) { a = mm16(BhT, LS, U0T, LS, tm, tn, 2, lane, z4); a = mm16(KhT, LS, VT, LS, tm, tn, 2, lane, a); dst = NTg; }
        else if (p == 2) { a = mm16(WzT, LS, Lrb, LS, tm, tn, 2, lane, z4);
            const u32x2 rv = *(const LAS u32x2*)(Rt + n * LS + m0);
            a[0] += __uint_as_float(rv.x << 16); a[1] += __uint_as_float(rv.x & 0xffff0000u); a[2] += __uint_as_float(rv.y << 16); a[3] += __uint_as_float(rv.y & 0xffff0000u);
            dst = RZg; }
        else { a = mm16(Lrb, LS, U0T, LS, tm, tn, 2, lane, z4); a = mm16(Lrk, LS, VT, LS, tm, tn, 2, lane, a); dst = Y0g; }
        *(GAS u32x2*)(dst + n * 64 + m0) = pack4(a);
      } }
    WG_BAR();
}

__device__ __forceinline__ f32x4 unpack4(u32x2 v) { f32x4 r; r[0] = __uint_as_float(v.x << 16); r[1] = __uint_as_float(v.x & 0xffff0000u); r[2] = __uint_as_float(v.y << 16); r[3] = __uint_as_float(v.y & 0xffff0000u); return r; }
struct ScanRegs { bf16x8 a0, a1; u32x2 ini[4], e[4], g[4]; };
__device__ __forceinline__ void scan_load(ScanRegs& R, const bf16* Ag, const bf16* Ig, const bf16* Eg, const bf16* Gg, int c, int tm, int lane, bool isY) {
    const int q4 = lane >> 4, l15 = lane & 15;
    const bf16* Au = Ag + (size_t)c * 4096 + (16 * tm + l15) * 64 + 8 * q4; const size_t io = (size_t)c * 4096 + 16 * tm + 4 * q4;
    R.a0 = *(const GAS bf16x8*)Au; R.a1 = *(const GAS bf16x8*)(Au + 32);
#pragma unroll
    for (int tn = 0; tn < 4; ++tn) R.ini[tn] = *(const GAS u32x2*)(Ig + io + (16 * tn + l15) * 64);
    if (isY) {
#pragma unroll
        for (int tn = 0; tn < 4; ++tn) { R.e[tn] = *(const GAS u32x2*)(Eg + io + (16 * tn + l15) * 64); R.g[tn] = *(const GAS u32x2*)(Gg + io + (16 * tn + l15) * 64); } }
}
__device__ __forceinline__ void rwkv_scan(Frame& F, int bh) {
    const int b = bh >> 3, h = bh & 7, lane = F.lane, w = F.wave, q4 = lane >> 4, l15 = lane & 15;
    LAS bf16* SB0 = (LAS bf16*)(F.lds + RING_OFF); LAS bf16* SB1 = SB0 + 64 * LS;
    unsigned char* ws = F.ws;
    const size_t ubase = (size_t)(b * NH + h) * NCH;
    const bool isY = w < 4; const int tm = w & 3;
    const bf16* Ag = (const bf16*)(ws + (isY ? WS_RZ : WS_MT)) + ubase * 4096; const bf16* Ig = (const bf16*)(ws + (isY ? WS_Y0 : WS_NT)) + ubase * 4096;
    const bf16* Eg = (const bf16*)(ws + WS_ET) + ubase * 4096; const bf16* Gg = (const bf16*)(ws + WS_GW) + ubase * 4096;
    ScanRegs cur, nxt;
    scan_load(cur, Ag, Ig, Eg, Gg, 0, tm, lane, isY);
    for (int u = F.tid; u < 64 * LS / 2; u += NWAVES * 64) ((LAS unsigned*)SB0)[u] = 0u;
    WG_BAR();
#pragma unroll 1
    for (int c = 0; c < NCH; ++c) {
        const LAS bf16* Sc = (c & 1) ? SB1 : SB0; LAS bf16* Sn = (c & 1) ? SB0 : SB1;
        scan_load(nxt, Ag, Ig, Eg, Gg, (c + 1 < NCH) ? c + 1 : c, tm, lane, isY);
        f32x4 acc[4];
#pragma unroll
        for (int tn = 0; tn < 4; ++tn) acc[tn] = unpack4(cur.ini[tn]);
#pragma unroll
        for (int tn = 0; tn < 4; ++tn) { const LAS bf16* bp = Sc + (16 * tn + l15) * LS + 8 * q4;
            acc[tn] = mfma16(cur.a0, *(const LAS bf16x8*)bp, acc[tn]); acc[tn] = mfma16(cur.a1, *(const LAS bf16x8*)(bp + 32), acc[tn]); }
        if (!isY) {
#pragma unroll
            for (int tn = 0; tn < 4; ++tn) *(LAS u32x2*)(Sn + (16 * tn + l15) * LS + 16 * tm + 4 * q4) = pack4(acc[tn]);
        } else {
            const size_t tg0 = (size_t)b * SEQ + c * 64 + 16 * tm + 4 * q4;
            f32x4 ev[4], gv[4];
#pragma unroll
            for (int tn = 0; tn < 4; ++tn) { ev[tn] = unpack4(cur.e[tn]); gv[tn] = unpack4(cur.g[tn]); }
#pragma unroll
            for (int r = 0; r < 4; ++r) {
                const float s = row16_sum((acc[0][r] + acc[1][r]) + (acc[2][r] + acc[3][r])); const float mean = s * (1.f / 64.f);
                float d[4], qq = 0.f;
#pragma unroll
                for (int tn = 0; tn < 4; ++tn) { d[tn] = acc[tn][r] - mean; qq += d[tn] * d[tn]; }
                const float rstd = 1.0f / sqrtf(row16_sum(qq) * (1.f / 64.f) + GN_EPS);
#pragma unroll
                for (int tn = 0; tn < 4; ++tn) F.OAB[(tg0 + r) * D + h * 64 + 16 * tn + l15] = (bf16)f2bf(d[tn] * rstd * gv[tn][r] + ev[tn][r]);
            }
        }
        WG_BAR();
        cur = nxt;
    }
}

struct Args { const float* in[28]; float* out; unsigned char* ws; int ph_lo, ph_hi; };
__global__ void __launch_bounds__(NWAVES * 64, 2) mk_fwd(Args args) {
    extern __shared__ __attribute__((aligned(16))) unsigned char lds[];
    Frame F;
    F.lds = (LAS unsigned char*)lds;
    F.MISC = (volatile LAS unsigned*)(F.lds + MISC_OFF);
    F.tid = threadIdx.x; F.lane = F.tid & 63; F.wave = __builtin_amdgcn_readfirstlane(F.tid >> 6);
    F.G = gridDim.x; { const int bx = blockIdx.x; F.vcu = (F.G % 8 == 0) ? (bx % 8) * (F.G / 8) + bx / 8 : bx; }
    unsigned char* ws = args.ws;
    F.ctl = (gu32*)(ws + WS_CTL); F.ws = ws;
#pragma unroll
    for (int i = 0; i < 28; ++i) F.in[i] = args.in[i];
    F.out = args.out;
    F.Wgu1 = (bf16*)(ws + WS_WGU1); F.Wdn1 = (bf16*)(ws + WS_WDN1); F.Win = (bf16*)(ws + WS_WIN); F.Wout = (bf16*)(ws + WS_WOUT); F.Wgu2 = (bf16*)(ws + WS_WGU2); F.Wdn2 = (bf16*)(ws + WS_WDN2);
    F.XN = (bf16*)(ws + WS_XN); F.H = (bf16*)(ws + WS_H); F.OAB = (bf16*)(ws + WS_OAB); F.Fm = (float*)(ws + WS_F);
    for (int u = F.tid; u < (LDS_BYTES - LDSCTL_OFF) / 4; u += NWAVES * 64) ((LAS unsigned*)(F.lds + LDSCTL_OFF))[u] = 0u;
    __syncthreads();
    XcdBarrier bar; bar.bar = (unsigned*)(F.ctl + CW_BAR); bar.x = 0; bar.st = nullptr;
    if (MK_ONE_LAUNCH) bar = xcd_barrier_post((unsigned*)(F.ctl + CW_BAR), F.MISC + 8);
    const int lo = args.ph_lo, hi = args.ph_hi;
#ifndef PH_MASK
#define PH_MASK 0xFFFF
#endif
#define IN(k) (((PH_MASK >> (k)) & 1) && lo <= (k) && (k) < hi)
#ifndef DBL_MASK
#define DBL_MASK 0
#endif
#define REP(k) for (int rep_ = 0; rep_ < ((((DBL_MASK) >> (k)) & 1) ? 2 : 1); ++rep_)
#define SEAM(k) do { if (IN(k) && IN((k) + 1)) xcd_barrier(bar); } while (0)

    if (IN(0)) REP(0) { p0_prologue(F); } SEAM(0);
    if (IN(1)) REP(1) { pg8::Gemm g{F.XN, F.Wgu1, M, NGU, D}; pg8::StaticOrder S; S.init(M, NGU, F.G, (int)blockIdx.x); pg8::EpiSwiGLU E{F.H, DFF};
        pg8::gemm_phase<pg8::EpiSwiGLU, pg8::StaticOrder, true, true>(F.lds + RING_OFF, g, S, E); } SEAM(1);
    if (IN(2)) REP(2) { pg8::Gemm g{F.H, F.Wdn1, M, D, DFF}; pg8::StaticOrder S; S.init(M, D, F.G, (int)blockIdx.x); pg8::EpiF32 E{F.Fm, D};
        pg8::gemm_phase<pg8::EpiF32, pg8::StaticOrder, true, true>(F.lds + RING_OFF, g, S, E); } SEAM(2);
    if (IN(3)) REP(3) { norm_pass(F, F.Fm, F.in[I_X], F.out, F.in[I_F1POST], 0.5f, F.in[I_MPRE], F.XN); } SEAM(3);
    if (IN(4)) REP(4) { pg8::Gemm g{F.XN, F.Win, M, DIN, D}; pg8::StaticOrder S; S.init(M, DIN, F.G, (int)blockIdx.x); pg8::EpiBf16 E{F.H, DIN};
        pg8::gemm_phase<pg8::EpiBf16, pg8::StaticOrder, true, true>(F.lds + RING_OFF, g, S, E); } SEAM(4);
    if (IN(5)) REP(5) {
        PrepRaw R; PairRaw RX; PairFrag A;
        const int NP = BATCH * NCH;
        if (F.vcu < NP) { rwkv_pair_issue(F, F.H, F.vcu / NCH, F.vcu % NCH, RX); rwkv_unit_issue(F, F.H, F.vcu / NCH, F.vcu % NCH, 0, R); }
        for (int pu = F.vcu; pu < NP; pu += F.G) {
            rwkv_pair_prologue(F, pu % NCH, RX, A);
            const int npu = (pu + F.G < NP) ? pu + F.G : -1;
            for (int h = 0; h < NH; ++h) {
                int ub = pu, uh = h + 1; if (uh == NH) { uh = 0; ub = npu >= 0 ? npu : pu; }
                const bool lastu = (h == NH - 1) && npu >= 0;
                rwkv_prep_unit(F, F.H, pu / NCH, pu % NCH, h, A, R, ub / NCH, ub % NCH, uh, RX, lastu ? npu / NCH : -1, lastu ? npu % NCH : 0); }
        }
        asm volatile("s_waitcnt vmcnt(0)" ::: "memory");
    } SEAM(5);
    if (IN(6)) REP(6) {
        if ((int)blockIdx.x < BATCH * NH) rwkv_scan(F, (int)blockIdx.x);
        else { ConvW CW; conv_load_w(F, CW); for (int u = (int)blockIdx.x - BATCH * NH; u < M / 32; u += F.G - BATCH * NH) conv_unit(F, F.H, u, CW); }
    } SEAM(6);
    if (IN(7)) REP(7) { pg8::Gemm g{F.OAB, F.Wout, M, D, D}; pg8::StaticOrder S; S.init(M, D, F.G, (int)blockIdx.x); pg8::EpiF32 E{F.Fm, D};
        pg8::gemm_phase<pg8::EpiF32, pg8::StaticOrder, true, true>(F.lds + RING_OFF, g, S, E); } SEAM(7);
    if (IN(8)) REP(8) { norm_pass(F, F.Fm, F.out, F.out, F.in[I_MPOST], 1.0f, F.in[I_F2PRE], F.XN); } SEAM(8);
    if (IN(9)) REP(9) { pg8::Gemm g{F.XN, F.Wgu2, M, NGU, D}; pg8::StaticOrder S; S.init(M, NGU, F.G, (int)blockIdx.x); pg8::EpiSwiGLU E{F.H, DFF};
        pg8::gemm_phase<pg8::EpiSwiGLU, pg8::StaticOrder, true, true>(F.lds + RING_OFF, g, S, E); } SEAM(9);
    if (IN(10)) REP(10) { pg8::Gemm g{F.H, F.Wdn2, M, D, DFF}; pg8::StaticOrder S; S.init(M, D, F.G, (int)blockIdx.x); pg8::EpiF32 E{F.Fm, D};
        pg8::gemm_phase<pg8::EpiF32, pg8::StaticOrder, true, true>(F.lds + RING_OFF, g, S, E); } SEAM(10);
    if (IN(11)) REP(11) { norm_pass(F, F.Fm, F.out, F.out, F.in[I_F2POST], 0.5f, nullptr, nullptr); }
#undef IN
#undef SEAM
}

extern "C" void kernel_launch(void* const* d_in, const int* in_sizes, int n_in, void* d_out, int out_size, void* d_ws, size_t ws_size, hipStream_t stream) {
    static int grid = 0;
    if (grid == 0) {
        if (n_in != 28 || in_sizes[0] != M * D || out_size != M * D || ws_size < WS_END) { fprintf(stderr, "kernel_launch: unexpected shapes (n_in %d, in0 %d, out %d, ws %zu); nothing launched\n", n_in, n_in > 0 ? in_sizes[0] : -1, out_size, ws_size); grid = -1; return; }
        int dev = 0, cus = 0, per_cu = 0;
        if (hipGetDevice(&dev) != hipSuccess || hipDeviceGetAttribute(&cus, hipDeviceAttributeMultiprocessorCount, dev) != hipSuccess) { grid = -1; return; }
        if (hipFuncSetAttribute((const void*)mk_fwd, hipFuncAttributeMaxDynamicSharedMemorySize, LDS_BYTES) != hipSuccess) { fprintf(stderr, "kernel_launch: hipFuncSetAttribute failed\n"); grid = -1; return; }
        if (hipOccupancyMaxActiveBlocksPerMultiprocessor(&per_cu, (const void*)mk_fwd, NWAVES * 64, LDS_BYTES) != hipSuccess || per_cu < 1) { fprintf(stderr, "kernel_launch: occupancy query says %d blocks per CU; nothing launched\n", per_cu); (void)hipGetLastError(); grid = -1; return; }
        grid = cus;
    }
    if (grid < 0) return;
    if (hipMemsetAsync((char*)d_ws + WS_CTL, 0, CTL_ZERO_BYTES, stream) != hipSuccess) { fprintf(stderr, "kernel_launch: hipMemsetAsync failed\n"); return; }
    Args a{};
    for (int i = 0; i < 28; ++i) a.in[i] = (const float*)d_in[i];
    a.out = (float*)d_out; a.ws = (unsigned char*)d_ws;
#if MK_ONE_LAUNCH
    a.ph_lo = 0; a.ph_hi = N_PHASES;
    hipLaunchKernelGGL(mk_fwd, dim3(grid), dim3(NWAVES * 64), LDS_BYTES, stream, a);
#else
    for (int p = 0; p < N_PHASES; ++p) { a.ph_lo = p; a.ph_hi = p + 1; hipLaunchKernelGGL(mk_fwd, dim3(grid), dim3(NWAVES * 64), LDS_BYTES, stream, a); }
#endif
    const hipError_t le = hipPeekAtLastError();
    if (le != hipSuccess) fprintf(stderr, "kernel_launch: launch failed: %s\n", hipGetErrorName(le));
}
```
